# Optimizing an MI355X kernel written in HIP

```python
import math
import jax, jax.numpy as jnp
from jax import lax
import numpy as np

D_MODEL = 2048
BATCH = 4
SEQ = 2048
DEPTH = 1

RET_HEADS = 8
RET_QK_DIM = 128
RET_V_DIM = 256
RET_CHUNK = 128
MOBA_HEADS = 16
MOBA_HEAD_DIM = 128
MOBA_BLOCK = 256
MOBA_TOPK = 3
MOBA_Q_CHUNK = 16
ROPE_THETA = 10000.0
NEG_INF = -1e30
N_EXPERTS = 32
TOP_K = 4
D_FF = D_MODEL
SWIGLU_LIMIT = 7.0
SWIGLU_ALPHA = 1.702
MOE_ROW_BLOCK = 256
RMS_EPS = 1e-5

RET_QK_W = RET_HEADS * RET_QK_DIM
RET_V_W = RET_HEADS * RET_V_DIM
MOBA_W = MOBA_HEADS * MOBA_HEAD_DIM
N_BRANCHES = 2
IN_SPLITS = (RET_QK_W, RET_QK_W, RET_V_W, RET_V_W, MOBA_W, MOBA_W, MOBA_W, N_BRANCHES * D_MODEL)
IN_WIDTH = sum(IN_SPLITS)

kernel_name = "hybrid_retention_moba_gated_moe"


def rms_norm(x, g):
    xf = x.astype(jnp.float32)
    y = xf * lax.rsqrt(jnp.mean(xf * xf, axis=-1, keepdims=True) + RMS_EPS)
    return (y * g.astype(jnp.float32)).astype(x.dtype)


def split_points(sizes):
    pts, acc = [], 0
    for s in sizes[:-1]:
        acc += s
        pts.append(acc)
    return pts


def rotary(x, positions):
    half = x.shape[-1] // 2
    inv_freq = ROPE_THETA ** (-jnp.arange(half, dtype=jnp.float32) / half)
    ang = positions.astype(jnp.float32)[..., None] * inv_freq
    cos = jnp.cos(ang)[:, :, None, :]
    sin = jnp.sin(ang)[:, :, None, :]
    xf = x.astype(jnp.float32)
    x1, x2 = xf[..., :half], xf[..., half:]
    out = jnp.concatenate([x1 * cos - x2 * sin, x2 * cos + x1 * sin], axis=-1)
    return out.astype(x.dtype)


def retention(q, k, v):
    B, S, H, dk = q.shape
    dv = v.shape[-1]
    C = RET_CHUNK
    N = S // C
    log_gamma = jnp.log1p(-jnp.exp2(-5.0 - jnp.arange(H, dtype=jnp.float32)))
    pos = jnp.arange(C, dtype=jnp.float32)
    qc = q.astype(jnp.float32).reshape(B, N, C, H, dk)
    kc = k.astype(jnp.float32).reshape(B, N, C, H, dk)
    vc = v.astype(jnp.float32).reshape(B, N, C, H, dv)
    diff = pos[:, None] - pos[None, :]
    intra_decay = jnp.where(diff[None] >= 0.0,
                            jnp.exp(jnp.maximum(diff, 0.0)[None] * log_gamma[:, None, None]), 0.0)
    scores = jnp.einsum('bnihd,bnjhd->bnhij', qc, kc) * intra_decay
    o_intra = jnp.einsum('bnhij,bnjhe->bnihe', scores, vc)
    k_w = jnp.exp((C - 1.0 - pos)[:, None] * log_gamma[None, :])
    inc = jnp.einsum('bnjhd,bnjhe->nbhde', kc * k_w[:, :, None], vc)
    chunk_decay = jnp.exp(C * log_gamma)[:, None, None]

    def step(state, inc_n):
        return chunk_decay * state + inc_n, state

    _, prev = lax.scan(step, jnp.zeros((B, H, dk, dv), jnp.float32), inc)
    q_w = jnp.exp((pos + 1.0)[:, None] * log_gamma[None, :])
    o_cross = jnp.einsum('bnihd,nbhde->bnihe', qc * q_w[:, :, None], prev)
    return (o_intra + o_cross).reshape(B, S, H, dv)


def moba_attention(q, k, v):
    B, S, H, Dh = q.shape
    L = MOBA_BLOCK
    QC = MOBA_Q_CHUNK
    n_kb = -(-S // L)
    s_pad = n_kb * L
    pad = ((0, 0), (0, s_pad - S), (0, 0), (0, 0))
    qh = q.transpose(0, 2, 1, 3)
    kh = jnp.pad(k, pad).transpose(0, 2, 1, 3)
    vh = jnp.pad(v, pad).transpose(0, 2, 1, 3)
    kb = kh.reshape(B, H, n_kb, L, Dh)
    vb = vh.reshape(B, H, n_kb, L, Dh)
    k_mean = jnp.mean(kb.astype(jnp.float32), axis=3)
    n_sel = min(MOBA_TOPK, n_kb)
    scale = Dh ** -0.5
    bi = jnp.arange(B)[:, None, None, None]
    hi = jnp.arange(H)[None, :, None, None]
    blk_ids = jnp.arange(n_kb)
    key_off = jnp.arange(L)
    q_off = jnp.arange(QC)

    def chunk(start):
        cur = start // L
        qc = lax.dynamic_slice_in_dim(qh, start, QC, axis=2)
        gate = jnp.einsum('bhqd,bhnd->bhqn', qc.astype(jnp.float32), k_mean)
        gate = jnp.where(blk_ids < cur, gate, NEG_INF)
        _, sel = lax.top_k(gate, n_sel)
        valid = sel < cur
        kg = kb[bi, hi, sel]
        vg = vb[bi, hi, sel]
        s_sel = jnp.einsum('bhqd,bhqnld->bhqnl', qc, kg).astype(jnp.float32) * scale
        s_sel = jnp.where(valid[..., None], s_sel, NEG_INF)
        k_own = lax.dynamic_slice_in_dim(kh, cur * L, L, axis=2)
        v_own = lax.dynamic_slice_in_dim(vh, cur * L, L, axis=2)
        s_own = jnp.einsum('bhqd,bhld->bhql', qc, k_own).astype(jnp.float32) * scale
        causal = (cur * L + key_off)[None, :] <= (start + q_off)[:, None]
        s_own = jnp.where(causal, s_own, NEG_INF)
        s_all = jnp.concatenate([s_sel.reshape(B, H, QC, n_sel * L), s_own], axis=-1)
        p = jax.nn.softmax(s_all, axis=-1).astype(v.dtype)
        p_sel = p[..., :n_sel * L].reshape(B, H, QC, n_sel, L)
        p_own = p[..., n_sel * L:]
        return (jnp.einsum('bhqnl,bhqnld->bhqd', p_sel, vg)
                + jnp.einsum('bhql,bhld->bhqd', p_own, v_own))

    starts = jnp.arange(S // QC) * QC
    out = lax.map(chunk, starts)
    return out.transpose(1, 0, 3, 2, 4).reshape(B, S, H * Dh)


def moe_ffn(h, router_w, router_b, w_gu, b_gu, w_down, b_down):
    B, S, D = h.shape
    T = B * S
    R = MOE_ROW_BLOCK
    ht = h.reshape(T, D)
    logits = (ht @ router_w + router_b).astype(jnp.float32)
    top_val, top_idx = lax.top_k(logits, TOP_K)
    comb = jax.nn.softmax(top_val, axis=-1)
    TK = T * TOP_K
    e_flat = top_idx.reshape(TK)
    order = jnp.argsort(e_flat)
    e_sorted = e_flat[order]
    tok_sorted = order // TOP_K
    w_sorted = comb.reshape(TK)[order]
    counts = jnp.zeros((N_EXPERTS,), jnp.int32).at[e_flat].add(1)
    starts = jnp.cumsum(counts) - counts
    padded = (counts + R - 1) // R * R
    pends = jnp.cumsum(padded)
    pstarts = pends - padded
    dest = pstarts[e_sorted] + (jnp.arange(TK) - starts[e_sorted])
    n_blocks = -(-TK // R) + N_EXPERTS
    P = n_blocks * R
    row_tok = jnp.zeros((P,), jnp.int32).at[dest].set(tok_sorted)
    row_w = jnp.zeros((P,), jnp.float32).at[dest].set(w_sorted)
    block_e = jnp.minimum(jnp.searchsorted(pends, jnp.arange(n_blocks) * R, side='right'),
                          N_EXPERTS - 1).astype(jnp.int32)
    x_rows = ht[row_tok].reshape(n_blocks, R, D)

    def expert_block(args):
        xb, e = args
        gu = xb @ w_gu[e] + b_gu[e]
        gate = jnp.minimum(gu[:, :D_FF], SWIGLU_LIMIT)
        up = jnp.clip(gu[:, D_FF:], -SWIGLU_LIMIT, SWIGLU_LIMIT)
        act = (up + 1.0) * gate * jax.nn.sigmoid(SWIGLU_ALPHA * gate)
        return act @ w_down[e] + b_down[e]

    y_rows = lax.map(expert_block, (x_rows, block_e)).reshape(P, D)
    y_rows = (y_rows * row_w[:, None]).astype(h.dtype)
    y = jnp.zeros((T, D), h.dtype).at[row_tok].add(y_rows)
    return y.reshape(B, S, D)


def setup_inputs(seed: int = 0) -> dict:
    key = jax.random.key(seed)
    ks = jax.random.split(key, 16)
    f32 = jnp.float32
    nrm = lambda k, shape, fan_in: jax.random.normal(k, shape, f32) * (fan_in ** -0.5)
    x = jax.random.normal(ks[0], (BATCH, SEQ, D_MODEL), f32)
    offset = jax.random.randint(ks[1], (BATCH, 1), 0, 4096, dtype=jnp.int32)
    positions = offset + jnp.arange(SEQ, dtype=jnp.int32)[None, :]
    return {
        "x": x,
        "positions": positions,
        "norm_mix_g": 1.0 + 0.01 * jax.random.normal(ks[2], (DEPTH, D_MODEL), f32),
        "w_in": nrm(ks[3], (DEPTH, D_MODEL, IN_WIDTH), D_MODEL),
        "ret_w_o": nrm(ks[4], (DEPTH, RET_V_W, D_MODEL), RET_V_W),
        "moba_w_o": nrm(ks[5], (DEPTH, MOBA_W, D_MODEL), MOBA_W),
        "w_out": nrm(ks[6], (DEPTH, D_MODEL, D_MODEL), D_MODEL),
        "norm_ffn_g": 1.0 + 0.01 * jax.random.normal(ks[7], (DEPTH, D_MODEL), f32),
        "router_w": nrm(ks[8], (DEPTH, D_MODEL, N_EXPERTS), D_MODEL),
        "router_b": 0.01 * jax.random.normal(ks[9], (DEPTH, N_EXPERTS), f32),
        "exp_w_gu": nrm(ks[10], (DEPTH, N_EXPERTS, D_MODEL, 2 * D_FF), D_MODEL),
        "exp_b_gu": 0.01 * jax.random.normal(ks[11], (DEPTH, N_EXPERTS, 2 * D_FF), f32),
        "exp_w_down": nrm(ks[12], (DEPTH, N_EXPERTS, D_FF, D_MODEL), D_FF),
        "exp_b_down": 0.01 * jax.random.normal(ks[13], (DEPTH, N_EXPERTS, D_MODEL), f32),
        "norm_final_g": 1.0 + 0.01 * jax.random.normal(ks[14], (D_MODEL,), f32),
    }


def reference(x, positions, norm_mix_g, w_in, ret_w_o, moba_w_o, w_out, norm_ffn_g,
              router_w, router_b, exp_w_gu, exp_b_gu, exp_w_down, exp_b_down, norm_final_g):
    B, S, D = x.shape
    for l in range(DEPTH):
        h = rms_norm(x, norm_mix_g[l])
        proj = jnp.einsum('bsd,df->bsf', h, w_in[l])
        rq, rk, rv, rg, mq, mk, mv, gates = jnp.split(proj, split_points(IN_SPLITS), axis=-1)
        rq = rotary(rq.reshape(B, S, RET_HEADS, RET_QK_DIM), positions)
        rk = rotary(rk.reshape(B, S, RET_HEADS, RET_QK_DIM), positions) * (RET_QK_DIM ** -0.5)
        o_ret = retention(rq, rk, rv.reshape(B, S, RET_HEADS, RET_V_DIM))
        o_ret = o_ret * lax.rsqrt(jnp.mean(o_ret * o_ret, axis=-1, keepdims=True) + RMS_EPS)
        o_ret = o_ret.astype(x.dtype) * jax.nn.silu(rg.reshape(B, S, RET_HEADS, RET_V_DIM))
        y_ret = o_ret.reshape(B, S, RET_V_W) @ ret_w_o[l]
        mq = rotary(mq.reshape(B, S, MOBA_HEADS, MOBA_HEAD_DIM), positions)
        mk = rotary(mk.reshape(B, S, MOBA_HEADS, MOBA_HEAD_DIM), positions)
        o_moba = moba_attention(mq, mk, mv.reshape(B, S, MOBA_HEADS, MOBA_HEAD_DIM))
        y_moba = o_moba @ moba_w_o[l]
        g = jax.nn.sigmoid(gates)
        merged = g[..., :D] * y_ret + g[..., D:] * y_moba
        x = x + merged @ w_out[l]
        h2 = rms_norm(x, norm_ffn_g[l])
        x = x + moe_ffn(h2, router_w[l], router_b[l], exp_w_gu[l], exp_b_gu[l],
                        exp_w_down[l], exp_b_down[l])
    return rms_norm(x, norm_final_g)
```

```cpp
#include <hip/hip_runtime.h>
#include <cstdio>
#include <cstdint>

constexpr int D = 2048, NB = 4, S = 2048, T = NB * S;
constexpr int RH = 8;
constexpr int MH = 16, MBLK = 256, NKB = S / MBLK;
constexpr int NE = 32, F = 2048;
constexpr int INW = 16384;
constexpr int C_RQ = 0, C_RK = 1024, C_RV = 2048, C_RG = 4096, C_MQ = 6144, C_MK = 8192, C_MV = 10240, C_GT = 12288;
constexpr int PMAX = T * 4 + NE * 256;
constexpr float EPS = 1e-5f;

#define LAS __attribute__((address_space(3)))
#define XB_TMO      128
#define XB_XCNT(j)  (256  + 64 * (j))
#define XB_XSUB(j)  (1280 + 64 * (j))
#define XB_XGEN(j)  (2304 + 64 * (j))
#define XB_TOP      3328
#define XB_TOPGEN   3392
#define XCD_BAR_WORDS 3456
#define XB_SPIN_CAP (1u << 18)

__device__ __forceinline__ unsigned xb_ld(unsigned* p)              { return __hip_atomic_load(p, __ATOMIC_RELAXED, __HIP_MEMORY_SCOPE_AGENT); }
__device__ __forceinline__ unsigned xb_add(unsigned* p, unsigned v) { return __hip_atomic_fetch_add(p, v, __ATOMIC_RELAXED, __HIP_MEMORY_SCOPE_AGENT); }
__device__ __forceinline__ unsigned xb_xcc_id() { return (unsigned)__builtin_amdgcn_s_getreg((3 << 11) | 20) & 0xFu; }
#define XB_SPIN(cond, bar) do { unsigned _sp = 0; while (cond) { __builtin_amdgcn_s_sleep(1); \
    if ((++_sp & 255u) == 0u) { if (xb_ld(&(bar)[XB_TMO])) break; if (_sp > XB_SPIN_CAP) { atomicAdd(&(bar)[XB_TMO], 1u); break; } } } } while (0)

struct XcdBarrier {
    unsigned* bar; unsigned x;
    unsigned* st;
};

__device__ __forceinline__ XcdBarrier xcd_barrier_post(unsigned* bar, unsigned* st) {
    XcdBarrier b; b.bar = bar; b.x = xb_xcc_id(); b.st = st;
    if (threadIdx.x == 0) (void)xb_add(&bar[XB_XCNT(b.x)], 1u);
    return b;
}
__device__ __forceinline__ void xcd_barrier_complete(unsigned* bar, unsigned x, unsigned& nloc, unsigned& nx) {
    const unsigned G = gridDim.x * gridDim.y * gridDim.z;
    unsigned sum, cnt, mine, sp = 0u;
    for (;;) {
        sum = 0u; cnt = 0u; mine = 0u;
#pragma unroll
        for (unsigned j = 0; j < 16; ++j) { const unsigned c = xb_ld(&bar[XB_XCNT(j)]); sum += c; cnt += (c > 0u) ? 1u : 0u; mine = (j == x) ? c : mine; }
        if (sum == G) break;
        __builtin_amdgcn_s_sleep(1);
        if ((++sp & 255u) == 0u) { if (xb_ld(&bar[XB_TMO])) break; if (sp > XB_SPIN_CAP) { atomicAdd(&bar[XB_TMO], 1u); break; } }
    }
    nloc = mine > 0u ? mine : 1u; nx = cnt > 0u ? cnt : 1u;
}

__device__ __forceinline__ void xcd_barrier(const XcdBarrier& b) {
    asm volatile("s_waitcnt vmcnt(0)" ::: "memory");
    __syncthreads();
    if (threadIdx.x == 0) {
        unsigned* bar = b.bar;
        __builtin_amdgcn_s_waitcnt(0);
        unsigned nloc = xb_ld(&b.st[0]), nx = xb_ld(&b.st[1]);
        if (nloc == 0u) { xcd_barrier_complete(bar, b.x, nloc, nx); __hip_atomic_store(&b.st[0], nloc, __ATOMIC_RELAXED, __HIP_MEMORY_SCOPE_AGENT); __hip_atomic_store(&b.st[1], nx, __ATOMIC_RELAXED, __HIP_MEMORY_SCOPE_AGENT); }
        const unsigned old = xb_add(&bar[XB_XSUB(b.x)], 1u);
        const unsigned gen = old / nloc;
        if (old + 1u == (gen + 1u) * nloc) {
            __builtin_amdgcn_fence(__ATOMIC_RELEASE, "agent");
            asm volatile("s_waitcnt vmcnt(0)" ::: "memory");
            const unsigned og = xb_add(&bar[XB_TOP], 1u);
            const unsigned tg = og / nx;
            if (og + 1u == (tg + 1u) * nx) xb_add(&bar[XB_TOPGEN], 1u);
            else XB_SPIN(xb_ld(&bar[XB_TOPGEN]) == tg, bar);
            __builtin_amdgcn_fence(__ATOMIC_ACQUIRE, "agent");
            xb_add(&bar[XB_XGEN(b.x)], 1u);
            asm volatile("s_waitcnt vmcnt(0)" ::: "memory");
        } else {
            XB_SPIN(xb_ld(&bar[XB_XGEN(b.x)]) == gen, bar);
            __builtin_amdgcn_fence(__ATOMIC_ACQUIRE, "agent");
            asm volatile("s_waitcnt vmcnt(0)" ::: "memory");
        }
    }
    __syncthreads();
}


constexpr size_t AL(size_t x) { return (x + 255) & ~(size_t)255; }
constexpr size_t WS_CTL   = 0;
constexpr int CNT_STRIDE = 64;
constexpr size_t CTL_QHEAD = 8192, CTL_BAR = 12288;
constexpr size_t CTL_BST = CTL_BAR + ((XCD_BAR_WORDS * 4 + 255) / 256) * 256;
constexpr size_t CTL_BYTES = CTL_BST + 1024 * 8;
constexpr size_t WS_ROPE  = AL(WS_CTL + CTL_BYTES);
constexpr size_t WS_YRET  = AL(WS_ROPE + (size_t)T * 64 * 2 * 4);
constexpr size_t WS_XMID  = AL(WS_YRET + (size_t)T * D * 4);
constexpr size_t WS_TOPI  = AL(WS_XMID + (size_t)T * D * 4);
constexpr size_t WS_SLOT  = AL(WS_TOPI + (size_t)T * 4 * 4);
constexpr size_t WB_HB    = AL(WS_SLOT + (size_t)T * 4 * 4);
constexpr size_t WB_WINT  = AL(WB_HB + (size_t)T * D * 2);
constexpr size_t WB_WRT   = AL(WB_WINT + (size_t)INW * D * 2);
constexpr size_t WB_WMT   = AL(WB_WRT + (size_t)D * D * 2);
constexpr size_t WB_WOT   = AL(WB_WMT + (size_t)D * D * 2);
constexpr size_t WB_WGUT  = AL(WB_WOT + (size_t)D * D * 2);
constexpr size_t WB_WDNT  = AL(WB_WGUT + (size_t)NE * 2 * F * D * 2);
constexpr size_t WB_PROJB = AL(WB_WDNT + (size_t)NE * D * F * 2);
constexpr size_t WB_KPART = AL(WB_PROJB + (size_t)T * INW * 2);
constexpr size_t WB_ORETB = AL(WB_KPART + (size_t)32 * 2 * 2048 * 4);
constexpr size_t WB_OMOBAB= AL(WB_ORETB + (size_t)T * D * 2);
constexpr size_t WB_MERGEDB=AL(WB_OMOBAB + (size_t)T * D * 2);
constexpr size_t WB_H2B   = AL(WB_MERGEDB + (size_t)T * D * 2);
constexpr size_t WB_LISTC = AL(WB_H2B + (size_t)T * D * 2);
constexpr size_t WB_ROWWC = AL(WB_LISTC + (size_t)NE * T * 4);
constexpr size_t WB_ACTB  = AL(WB_ROWWC + (size_t)NE * T * 4);
constexpr size_t WB_YROWB = AL(WB_ACTB + (size_t)PMAX * F * 2);
constexpr size_t WB_SCR   = AL(WB_YROWB + (size_t)PMAX * D * 2);
constexpr size_t WB_HB8   = AL(WB_SCR + (size_t)1024 * 512 * 16);
constexpr size_t WB_WINT8 = AL(WB_HB8 + (size_t)T * D);
constexpr size_t WB_END2  = AL(WB_WINT8 + (size_t)INW * D);
constexpr int LDS_BYTES = 160 * 1024;
constexpr int LDS_MINI = 128 * 1024;
constexpr int LDS_TAB = 144 * 1024;

__device__ __forceinline__ int opaque_tid() { int t = threadIdx.x; asm volatile("" : "+v"(t)); return t; }
__device__ __forceinline__ float wave_sum(float v) {
#pragma unroll
    for (int o = 32; o >= 1; o >>= 1) v += __shfl_xor(v, o);
    return v;
}
typedef unsigned short bf16_t;
typedef short bf16x8 __attribute__((ext_vector_type(8)));
typedef float f32x4 __attribute__((ext_vector_type(4)));
typedef unsigned u32x4 __attribute__((ext_vector_type(4)));
typedef unsigned u32x2 __attribute__((ext_vector_type(2)));

__device__ __forceinline__ unsigned cvt_pk_bf16(float lo, float hi) { unsigned r; asm volatile("v_cvt_pk_bf16_f32 %0, %1, %2" : "=v"(r) : "v"(lo), "v"(hi)); return r; }
constexpr float WSCALE = 64.0f, WSCALE_INV = 1.0f / 64.0f;
constexpr float YSCALE = 16.0f, YSCALE_INV = 1.0f / 16.0f;
__device__ __forceinline__ unsigned pk4_fp8(float a, float b, float c, float d) {
    unsigned w = 0u;
    w = (unsigned)__builtin_amdgcn_cvt_pk_fp8_f32(a, b, (int)w, false);
    w = (unsigned)__builtin_amdgcn_cvt_pk_fp8_f32(c, d, (int)w, true);
    return w;
}
__device__ __forceinline__ float bf_lo(unsigned w) { return __uint_as_float(w << 16); }
__device__ __forceinline__ float bf_hi(unsigned w) { return __uint_as_float(w & 0xffff0000u); }
__device__ __forceinline__ float fast_sigmoid(float x) { return __builtin_amdgcn_rcpf(1.0f + __expf(-x)); }


struct BgOff { static constexpr bool ON = false; };
template <int KK, int NN>
struct BgConv {
    static constexpr bool ON = true;
    const float* src; bf16_t* dst; char* scratch;
    int c, G, step, nsteps;
    int cur_step, cur_valid, par;
    unsigned dsrc[2], drd, dsto, dscr;
    __device__ __forceinline__ void init(const float* s_, bf16_t* d_, char* scr, int nmat, int c_, int G_) {
        src = s_; dst = d_; scratch = scr + (size_t)c_ * 512 * 16; c = c_; G = G_; step = 0; cur_step = 0; cur_valid = 0; par = 0;
        const int total = nmat * (KK / 64) * (NN / 256); nsteps = 4 * ((total - c_ + G_ - 1) / G_);
    }
    __device__ __forceinline__ void lanes() {
        const int tid = opaque_tid();
        dscr = (unsigned)tid * 16u;
        const int wid = tid >> 6, lane = tid & 63;
#pragma unroll
        for (int q = 0; q < 2; ++q) { const int r = 4 * (wid * 2 + q) + (lane >> 4), pos = lane & 15, cidx = (pos - (r >> 3)) & 15; dsrc[q] = (unsigned)(r * NN * 4 + cidx * 16); }
        const int n = tid >> 3, k8 = tid & 7;
        drd = (unsigned)((8 * k8) * 256 + (((n >> 2) + k8) & 15) * 16 + (n & 3) * 4);
        dsto = (unsigned)(n * KK + 8 * k8);
    }
    __device__ __forceinline__ void bases(int s, const char*& sb, char*& db) const {
        const int jt = s >> 2, q = s & 3, tile = c + G * jt;
        constexpr int ntk = KK / 64, ntn = NN / 256;
        const int mat = tile / (ntk * ntn), rem = tile % (ntk * ntn), kt = rem / ntn, ntile = rem % ntn;
        sb = (const char*)src + ((size_t)(mat * KK + kt * 64) * NN + ntile * 256 + 64 * q) * 4;
        db = (char*)dst + ((size_t)(mat * NN + ntile * 256 + 64 * q) * KK + kt * 64);
    }
    __device__ __forceinline__ void issue(LAS unsigned char* lds, int wid) {
        const int s = step < nsteps ? step : nsteps - 1;
        const char* sb; char* db; bases(s, sb, db); (void)db;
#pragma unroll
        for (int q = 0; q < 2; ++q)
            __builtin_amdgcn_global_load_lds((const unsigned*)(sb + dsrc[q]), (LAS unsigned*)(lds + LDS_MINI + par * 16384 + (wid * 2 + q) * 1024), 16, 0, 2);
        par ^= 1; cur_step = s; cur_valid = step < nsteps ? 1 : 0; if (step < nsteps) ++step;
    }
    __device__ __forceinline__ void consume(LAS unsigned char* lds) {
        const LAS unsigned char* rp = lds + LDS_MINI + (par ^ 1) * 16384 + drd;
        float v[8];
#pragma unroll
        for (int j = 0; j < 8; ++j) v[j] = *(const LAS float*)(rp + j * 256);
        u32x2 w; w.x = pk4_fp8(v[0] * WSCALE, v[1] * WSCALE, v[2] * WSCALE, v[3] * WSCALE); w.y = pk4_fp8(v[4] * WSCALE, v[5] * WSCALE, v[6] * WSCALE, v[7] * WSCALE);
        const char* sb; char* db; bases(cur_step, sb, db); (void)sb;
        char* p = cur_valid ? db + dsto : scratch + dscr;
        __builtin_nontemporal_store(w, (u32x2*)p);
        cur_valid = 0;
    }
};

namespace g8 {
constexpr int BM = 256, BK = 64, HALF = 128, HTB = HALF * BK * 2, STAGE_BYTES = 8 * HTB, NXCD = 8, WGM = 8;
__host__ __device__ __forceinline__ int lds_byte(int r, int c) { const int st = (r >> 4) * 2 + (c >> 5), rr = r & 15, cc = c & 31, ob = rr * 64 + cc * 2; return st * 1024 + (ob ^ (((ob >> 9) & 1) << 5)); }
__host__ __device__ __forceinline__ void stage_rc(int b, int& R, int& C) { const int st = b / 1024, sb = b % 1024, swz = sb ^ (((sb >> 9) & 1) << 5); R = (st >> 1) * 16 + swz / 64; C = (st & 1) * 32 + (swz % 64) / 2; }
__host__ __device__ __forceinline__ int perm32(int rho) { const int n = rho >> 4, i = rho & 15; return 8 * (i >> 2) + 4 * n + (i & 3); }

struct Unit { const char* A; const char* B; int pm, pn, e, aux; };

template <class P, class BG>
__device__ __forceinline__ void gemm_phase(LAS unsigned char* lds, const P& p, BG& bg) {
    const int tid = opaque_tid(), wid = __builtin_amdgcn_readfirstlane(tid >> 6), lane = tid & 63, wr = wid >> 2, wc = wid & 3, fr = lane & 15, fq = lane >> 4;
    const int K = p.K(), nt = K / BK;
    Unit cur, nxt; int ui = 0;
    if (!p.next(0, cur)) return;
    int sR[2], sC[2];
#pragma unroll
    for (int i = 0; i < 2; ++i) stage_rc(tid * 16 + i * 8192, sR[i], sC[i]);
    unsigned voffB[2][2], voffA[2][2], voffAn[2][2];
#pragma unroll
    for (int h = 0; h < 2; ++h)
#pragma unroll
        for (int i = 0; i < 2; ++i) { voffB[h][i] = p.boff(h, sR[i]) + (unsigned)sC[i] * 2u; voffA[h][i] = p.aoff(cur, h, sR[i]) + (unsigned)sC[i] * 2u; voffAn[h][i] = voffA[h][i]; }
    const size_t kstep = (size_t)(BK * 2);
    const unsigned ldsw = (unsigned)wid * 1024u;
    const int aoff = lds_byte(wr * 64 + fr, fq * 8), boff = lds_byte(wc * 32 + fr, fq * 8);
#define G8_SA(b, h) (((b) * 2 + (h)) * HTB)
#define G8_SB(b, h) ((4 + (b) * 2 + (h)) * HTB)
#define G8_STAGE(bufoff, gbase, voff) do { _Pragma("unroll") for (int _i = 0; _i < 2; ++_i) \
        __builtin_amdgcn_global_load_lds((const unsigned*)((const char*)(gbase) + (voff)[_i]), (LAS unsigned*)(lds + (bufoff) + ldsw + _i * 8192), 16, 0, 0); } while (0)
    typedef int i32x4_t __attribute__((ext_vector_type(4))); typedef int i32x8_t __attribute__((ext_vector_type(8)));
#define G8_CAT(x0, x1) __builtin_shufflevector(x0, x1, 0, 1, 2, 3, 4, 5, 6, 7)
#define G8_LO(x) __builtin_bit_cast(bf16x8, __builtin_shufflevector(x, x, 0, 1, 2, 3))
#define G8_HI(x) __builtin_bit_cast(bf16x8, __builtin_shufflevector(x, x, 4, 5, 6, 7))
#define G8_LDA(dst, b, h) do { _Pragma("unroll") for (int m = 0; m < 4; ++m) dst[m] = G8_CAT(*(const LAS i32x4_t*)(lds + G8_SA(b, h) + aoff + m * 2048), *(const LAS i32x4_t*)(lds + G8_SA(b, h) + aoff + m * 2048 + 1024)); } while (0)
#define G8_LDB(dst, b, h) do { _Pragma("unroll") for (int n = 0; n < 2; ++n) dst[n] = G8_CAT(*(const LAS i32x4_t*)(lds + G8_SB(b, h) + boff + n * 2048), *(const LAS i32x4_t*)(lds + G8_SB(b, h) + boff + n * 2048 + 1024)); } while (0)
#define G8_MMA(ai, bj, At, Bt) do { __builtin_amdgcn_s_setprio(1); \
        if constexpr (P::F8) { _Pragma("unroll") for (int m = 0; m < 4; ++m) _Pragma("unroll") for (int n = 0; n < 2; ++n) \
            asm volatile("v_mfma_scale_f32_16x16x128_f8f6f4 %0, %1, %2, %0, %3, %3 op_sel_hi:[0,0,0]" : "+v"(acc[ai][bj][m][n]) : "v"(Bt[n]), "v"(At[m]), "v"(one_scale)); } \
        else { _Pragma("unroll") for (int m = 0; m < 4; ++m) _Pragma("unroll") for (int n = 0; n < 2; ++n) { \
            acc[ai][bj][m][n] = __builtin_amdgcn_mfma_f32_16x16x32_bf16(G8_LO(Bt[n]), G8_LO(At[m]), acc[ai][bj][m][n], 0, 0, 0); \
            acc[ai][bj][m][n] = __builtin_amdgcn_mfma_f32_16x16x32_bf16(G8_HI(Bt[n]), G8_HI(At[m]), acc[ai][bj][m][n], 0, 0, 0); } } \
        __builtin_amdgcn_s_setprio(0); } while (0)
#define G8_WAIT_V(n) asm volatile("s_waitcnt vmcnt(" #n ")" ::: "memory")
#define G8_WAIT_L(n) asm volatile("s_waitcnt lgkmcnt(" #n ")" ::: "memory")
#define G8_BAR __builtin_amdgcn_s_barrier()
#define G8_SCHED __builtin_amdgcn_sched_barrier(0)
    f32x4 acc[2][2][4][2];
#pragma unroll
    for (int a = 0; a < 2; ++a)
#pragma unroll
        for (int b = 0; b < 2; ++b)
#pragma unroll
            for (int m = 0; m < 4; ++m)
#pragma unroll
                for (int n = 0; n < 2; ++n) acc[a][b][m][n] = (f32x4){0.f, 0.f, 0.f, 0.f};
    i32x8_t At[4], B0[2], B1[2];
    const int one_scale = 0x7f7f7f7f;
    const char* cA = cur.A; const char* cB = cur.B;
    G8_STAGE(G8_SB(0, 0), cB, voffB[0]); G8_STAGE(G8_SB(0, 1), cB, voffB[1]); G8_STAGE(G8_SA(0, 0), cA, voffA[0]); G8_STAGE(G8_SA(0, 1), cA, voffA[1]);
    if (wr == 1) G8_BAR;
    G8_WAIT_V(2); G8_BAR;
    G8_STAGE(G8_SB(1, 0), cB + kstep, voffB[0]); G8_STAGE(G8_SA(1, 0), cA + kstep, voffA[0]); G8_STAGE(G8_SB(1, 1), cB + kstep, voffB[1]);
    if constexpr (BG::ON) {
        G8_STAGE(G8_SB(1, 1), cB + kstep, voffB[1]);
        __builtin_amdgcn_global_load_lds((const unsigned*)((const char*)(cA + kstep) + voffA[0][0]), (LAS unsigned*)(lds + G8_SA(1, 0) + ldsw), 16, 0, 0);
        G8_WAIT_V(9);
    } else { G8_WAIT_V(6); }
    G8_BAR;
    for (;;) {
        const bool has_next = p.next(ui + 1, nxt);
        const char* nA = has_next ? nxt.A : cA; const char* nB = has_next ? nxt.B : cB;
        for (int t = 0; t < nt; t += 2) {
            const bool last = (t == nt - 2);
            const char* a1 = cA + (size_t)(t + 1) * kstep;
            const char* a2 = last ? nA : cA + (size_t)(t + 2) * kstep; const char* b2 = last ? nB : cB + (size_t)(t + 2) * kstep;
            const char* a3 = a2 + kstep; const char* b3 = b2 + kstep;
            const bool usen = P::AVAR && last && has_next;
            if constexpr (P::AVAR) {
                if (usen) {
#pragma unroll
                    for (int h = 0; h < 2; ++h)
#pragma unroll
                        for (int i = 0; i < 2; ++i) voffAn[h][i] = p.aoff(nxt, h, sR[i]) + (unsigned)sC[i] * 2u;
                }
            }
#define G8_STAGE_A2(bufoff, gbase, h) do { _Pragma("unroll") for (int _i = 0; _i < 2; ++_i) \
        __builtin_amdgcn_global_load_lds((const unsigned*)((const char*)(gbase) + (usen ? voffAn[h][_i] : voffA[h][_i])), (LAS unsigned*)(lds + (bufoff) + ldsw + _i * 8192), 16, 0, 0); } while (0)
            G8_LDB(B0, 0, 0); G8_LDB(B1, 0, 1); G8_SCHED; G8_LDA(At, 0, 0); G8_STAGE(G8_SA(1, 1), a1, voffA[1]);
            if constexpr (BG::ON) { G8_WAIT_V(11); } else { G8_WAIT_V(8); }
            G8_WAIT_L(0); G8_BAR; G8_MMA(0, 0, At, B0); G8_MMA(0, 1, At, B1); G8_BAR; G8_SCHED;
            G8_LDA(At, 0, 1); G8_STAGE(G8_SB(0, 0), b2, voffB[0]); G8_STAGE(G8_SB(0, 1), b2, voffB[1]); G8_STAGE_A2(G8_SA(0, 0), a2, 0);
            if constexpr (BG::ON) { G8_WAIT_V(11); } else { G8_WAIT_V(8); }
            G8_WAIT_L(0); G8_BAR; G8_MMA(1, 0, At, B0); G8_MMA(1, 1, At, B1); G8_BAR; G8_SCHED;
            G8_LDB(B0, 1, 0); G8_LDB(B1, 1, 1); G8_SCHED; G8_LDA(At, 1, 0); G8_STAGE_A2(G8_SA(0, 1), a2, 1);
            G8_WAIT_V(8); G8_WAIT_L(0); G8_BAR; G8_MMA(0, 0, At, B0); G8_MMA(0, 1, At, B1); G8_BAR; G8_SCHED;
            G8_LDA(At, 1, 1); G8_STAGE(G8_SB(1, 0), b3, voffB[0]); G8_STAGE(G8_SB(1, 1), b3, voffB[1]); G8_STAGE_A2(G8_SA(1, 0), a3, 0);
            if constexpr (BG::ON) { bg.consume(lds); bg.issue(lds, wid); G8_WAIT_V(11); } else { G8_WAIT_V(8); }
            G8_WAIT_L(0); G8_BAR; G8_MMA(1, 0, At, B0); G8_MMA(1, 1, At, B1); G8_BAR; G8_SCHED;
        }
        if constexpr (P::F8) asm volatile("s_nop 7\n\ts_nop 7\n\ts_nop 7" ::: "memory");
        if (wr == 0) G8_BAR;
        { int tz = threadIdx.x; asm volatile("" : "+v"(tz));
          const int l2 = tz & 63; p.epi(acc, cur, wr, wc, l2 & 15, l2 >> 4); }
        if (!has_next) break;
#pragma unroll
        for (int a = 0; a < 2; ++a)
#pragma unroll
            for (int b = 0; b < 2; ++b)
#pragma unroll
                for (int m = 0; m < 4; ++m)
#pragma unroll
                    for (int n = 0; n < 2; ++n) acc[a][b][m][n] = (f32x4){0.f, 0.f, 0.f, 0.f};
        cur = nxt; cA = nA; cB = nB; ++ui;
        if (wr == 1) G8_BAR;
        if constexpr (P::AVAR) {
#pragma unroll
            for (int h = 0; h < 2; ++h)
#pragma unroll
                for (int i = 0; i < 2; ++i) voffA[h][i] = voffAn[h][i];
        }
    }
    G8_WAIT_V(0);
    G8_BAR;
    if constexpr (BG::ON) { bg.consume(lds); G8_WAIT_L(0); G8_BAR; }
#undef G8_STAGE_A2
#undef G8_SA
#undef G8_SB
#undef G8_STAGE
#undef G8_LDA
#undef G8_LDB
#undef G8_MMA
#undef G8_CAT
#undef G8_LO
#undef G8_HI
#undef G8_WAIT_V
#undef G8_WAIT_L
#undef G8_BAR
#undef G8_SCHED
}
__device__ __forceinline__ bool static_unit(int i, int G, int c, int nM, int nN, int& pm, int& pn) {
    const int nwg = nM * nN; const long L = (long)i * G + c; if (L >= nwg) return false;
    int wgid = (int)L; { const int q = nwg / NXCD, r = nwg % NXCD, xcd = wgid % NXCD, off = wgid / NXCD; wgid = (xcd < r ? xcd * (q + 1) : r * (q + 1) + (xcd - r) * q) + off; }
    const int nig = WGM * nN, gid = wgid / nig, fm = gid * WGM, gsz = (nM - fm) < WGM ? (nM - fm) : WGM;
    pm = fm + ((wgid % nig) % gsz); pn = (wgid % nig) / gsz; return true;
}
}

__device__ __forceinline__ void p0_rmsnorm_bf16(const float* __restrict__ x, const float* __restrict__ g, bf16_t* __restrict__ out, unsigned char* __restrict__ out8, int wg, int nwg) {
    const int tz = opaque_tid(), wid = tz >> 6, lane = tz & 63;
    for (int row = wg * 8 + wid; row < T; row += nwg * 8) {
        const float4* xr = (const float4*)(x + (size_t)row * D);
        float4 v[8]; float ss = 0.f;
#pragma unroll
        for (int i = 0; i < 8; ++i) { v[i] = xr[lane + 64 * i]; ss += v[i].x * v[i].x + v[i].y * v[i].y + v[i].z * v[i].z + v[i].w * v[i].w; }
        ss = wave_sum(ss);
        const float r = rsqrtf(ss * (1.0f / D) + EPS);
#pragma unroll
        for (int i = 0; i < 8; ++i) {
            const float4 gg = ((const float4*)g)[lane + 64 * i];
            u32x2 w; w.x = cvt_pk_bf16(v[i].x * r * gg.x, v[i].y * r * gg.y); w.y = cvt_pk_bf16(v[i].z * r * gg.z, v[i].w * r * gg.w);
            *(u32x2*)(out + (size_t)row * D + (lane + 64 * i) * 4) = w;
            *(unsigned*)(out8 + (size_t)row * D + (lane + 64 * i) * 4) = pk4_fp8(v[i].x * r * gg.x, v[i].y * r * gg.y, v[i].z * r * gg.z, v[i].w * r * gg.w);
        }
    }
}
__device__ __forceinline__ void p0_rope(const int* __restrict__ pos, float* __restrict__ cs, int wg, int nwg) {
    for (int idx = wg * 512 + opaque_tid(); idx < T * 64; idx += nwg * 512) {
        const int t = idx >> 6, i = idx & 63;
        const float inv = powf(10000.0f, -(float)i / 64.0f);
        const float ang = (float)pos[t] * inv;
        float sn, cn; sincosf(ang, &sn, &cn);
        ((unsigned*)cs)[idx] = cvt_pk_bf16(cn, sn);
    }
}
__host__ __device__ __forceinline__ bool p1_fp8_unit(int pn) { return pn >= 48; }
struct TrRegs { f32x4 a[4], b[4]; };
__device__ __forceinline__ void tr_load(TrRegs& r, const float* __restrict__ src, int K, int N, int ntk, int ntn, int tile, int n4, int kp) {
    const int mat = tile / (ntk * ntn), rem = tile % (ntk * ntn), kt = rem / ntn, ntile = rem % ntn;
    const float* sp = src + ((size_t)mat * K + kt * 64 + 2 * kp) * N + ntile * 256 + 4 * n4;
#pragma unroll
    for (int s = 0; s < 4; ++s) { r.a[s] = __builtin_nontemporal_load((const f32x4*)(sp + 64 * s)); r.b[s] = __builtin_nontemporal_load((const f32x4*)(sp + N + 64 * s)); }
}
__device__ __forceinline__ void tr_lds_write(const TrRegs& r, LAS unsigned* lt, int n4, int kp) {
#pragma unroll
    for (int s = 0; s < 4; ++s) {
        const int n = 64 * s + 4 * n4;
        lt[(n + 0) * 33 + kp] = cvt_pk_bf16(r.a[s][0], r.b[s][0]); lt[(n + 1) * 33 + kp] = cvt_pk_bf16(r.a[s][1], r.b[s][1]);
        lt[(n + 2) * 33 + kp] = cvt_pk_bf16(r.a[s][2], r.b[s][2]); lt[(n + 3) * 33 + kp] = cvt_pk_bf16(r.a[s][3], r.b[s][3]);
    }
}
__device__ __forceinline__ void tr_store(bf16_t* __restrict__ dst, int K, int N, int ntk, int ntn, int tile, const LAS unsigned* lt, int t) {
    const int mat = tile / (ntk * ntn), rem = tile % (ntk * ntn), kt = rem / ntn, ntile = rem % ntn;
    bf16_t* dp = dst + ((size_t)mat * N + ntile * 256) * K + kt * 64;
#pragma unroll
    for (int q = 0; q < 4; ++q) {
        const int chunk = t + 512 * q, n = chunk >> 3, k8 = chunk & 7;
        u32x4 w; w.x = lt[n * 33 + 4 * k8]; w.y = lt[n * 33 + 4 * k8 + 1]; w.z = lt[n * 33 + 4 * k8 + 2]; w.w = lt[n * 33 + 4 * k8 + 3];
        *(u32x4*)(dp + (size_t)n * K + k8 * 8) = w;
    }
}
__device__ __forceinline__ void tr_store8(unsigned char* __restrict__ dst, int K, int N, int ntk, int ntn, int tile, const LAS unsigned* lt, int t) {
    const int mat = tile / (ntk * ntn), rem = tile % (ntk * ntn), kt = rem / ntn, ntile = rem % ntn;
    unsigned char* dp = dst + ((size_t)mat * N + ntile * 256) * K + kt * 64;
#pragma unroll
    for (int q = 0; q < 2; ++q) {
        const int chunk = t + 512 * q, n = chunk >> 2, k16 = chunk & 3;
        unsigned v[8];
#pragma unroll
        for (int j = 0; j < 8; ++j) v[j] = lt[n * 33 + 8 * k16 + j];
        u32x4 w;
        w.x = pk4_fp8(bf_lo(v[0]) * WSCALE, bf_hi(v[0]) * WSCALE, bf_lo(v[1]) * WSCALE, bf_hi(v[1]) * WSCALE);
        w.y = pk4_fp8(bf_lo(v[2]) * WSCALE, bf_hi(v[2]) * WSCALE, bf_lo(v[3]) * WSCALE, bf_hi(v[3]) * WSCALE);
        w.z = pk4_fp8(bf_lo(v[4]) * WSCALE, bf_hi(v[4]) * WSCALE, bf_lo(v[5]) * WSCALE, bf_hi(v[5]) * WSCALE);
        w.w = pk4_fp8(bf_lo(v[6]) * WSCALE, bf_hi(v[6]) * WSCALE, bf_lo(v[7]) * WSCALE, bf_hi(v[7]) * WSCALE);
        *(u32x4*)(dp + (size_t)n * K + k16 * 16) = w;
    }
}
template <bool NOSTORE = false, bool F8 = false, bool MIX = false>
__device__ __forceinline__ void p0_transpose(const float* __restrict__ src, bf16_t* __restrict__ dst, int K, int N, int nmat, LAS unsigned* lt, int wg, int nwg, unsigned char* dst8 = nullptr) {
    const int t = opaque_tid(), n4 = t & 15, kp = t >> 4;
    const int ntk = K / 64, ntn = N / 256, total = nmat * ntk * ntn;
    TrRegs r0, r1;
    const int last = total - 1;
    int tile = wg;
    if (tile >= total) return;
    tr_load(r0, src, K, N, ntk, ntn, min(tile, last), n4, kp);
    tr_load(r1, src, K, N, ntk, ntn, min(tile + nwg, last), n4, kp);
    for (; tile < total; tile += 2 * nwg) {
        __syncthreads();
        tr_lds_write(r0, lt, n4, kp);
        __syncthreads();
        tr_load(r0, src, K, N, ntk, ntn, min(tile + 2 * nwg, last), n4, kp);
        if (!NOSTORE) { if constexpr (MIX) { if (p1_fp8_unit(tile % ntn)) tr_store8(dst8, K, N, ntk, ntn, tile, lt, t); else tr_store(dst, K, N, ntk, ntn, tile, lt, t); }
                        else if constexpr (F8) tr_store8((unsigned char*)dst, K, N, ntk, ntn, tile, lt, t); else tr_store(dst, K, N, ntk, ntn, tile, lt, t); }
        __syncthreads();
        tr_lds_write(r1, lt, n4, kp);
        __syncthreads();
        tr_load(r1, src, K, N, ntk, ntn, min(tile + 3 * nwg, last), n4, kp);
        if (!NOSTORE && tile + nwg < total) { if constexpr (MIX) { if (p1_fp8_unit((tile + nwg) % ntn)) tr_store8(dst8, K, N, ntk, ntn, tile + nwg, lt, t); else tr_store(dst, K, N, ntk, ntn, tile + nwg, lt, t); }
                        else if constexpr (F8) tr_store8((unsigned char*)dst, K, N, ntk, ntn, tile + nwg, lt, t); else tr_store(dst, K, N, ntk, ntn, tile + nwg, lt, t); }
    }
    __syncthreads();
}


template <bool F8_>
struct P1PolicyT {
    const char* hA; const char* WinT; bf16_t* projb; const float* rope; float* kpart; int G, c, i0, icnt;
    static constexpr bool AVAR = false; static constexpr bool F8 = F8_;
    static constexpr int ES = F8_ ? 1 : 2;
    __device__ __forceinline__ int K() const { return F8_ ? D / 2 : D; }
    __device__ __forceinline__ bool next(int i, g8::Unit& u) const {
        if (i >= icnt) return false;
        int pm, idx; if (!g8::static_unit(i0 + i, G, c, T / 256, F8_ ? 16 : 48, pm, idx)) return false;
        const int pn = F8_ ? idx + 48 : idx;
        u.pm = pm; u.pn = pn; u.e = 0; u.aux = 0; u.A = hA + (size_t)pm * 256 * D * ES; u.B = WinT + (size_t)pn * 256 * D * ES; return true;
    }
    __device__ __forceinline__ unsigned aoff(const g8::Unit&, int h, int R) const { return (unsigned)((h * 128 + R) * D * ES); }
    __device__ __forceinline__ unsigned boff(int h, int R) const { return (unsigned)((128 * (R >> 6) + 64 * h + 32 * ((R >> 5) & 1) + g8::perm32(R & 31)) * D * ES); }
    template <bool SCALE, bool KSUM>
    __device__ __forceinline__ void epi_rot(const f32x4 (&acc)[2][2][4][2], const g8::Unit& u, int wr, int fr, int colb, int dd0, int ksum_col) const {
        const unsigned* rp = (const unsigned*)rope;
        const float sc = SCALE ? 0.08838834764831845f : 1.0f;
        constexpr int NB2 = KSUM ? 1 : 2;
        float cs0[2][2][4];
#pragma unroll
        for (int b = 0; b < 2; ++b)
#pragma unroll
            for (int n = 0; n < 2; ++n)
#pragma unroll
                for (int j = 0; j < 4; ++j) cs0[b][n][j] = 0.f;
#pragma unroll
        for (int g0 = 0; g0 < 8; g0 += NB2) {
            u32x4 ra[NB2], rb[NB2];
#pragma unroll
            for (int mm = 0; mm < NB2; ++mm) {
                const int ai = (g0 + mm) >> 2, m = (g0 + mm) & 3;
                const int t = 256 * u.pm + 128 * ai + 64 * wr + 16 * m + fr;
                ra[mm] = *(const u32x4*)(rp + (size_t)t * 64 + dd0); rb[mm] = *(const u32x4*)(rp + (size_t)t * 64 + dd0 + 4);
            }
#pragma unroll
            for (int mm = 0; mm < NB2; ++mm) {
                const int ai = (g0 + mm) >> 2, m = (g0 + mm) & 3;
                const int t = 256 * u.pm + 128 * ai + 64 * wr + 16 * m + fr;
                float o[2][2][4];
#pragma unroll
                for (int n = 0; n < 2; ++n) {
                    const u32x4 w = n ? rb[mm] : ra[mm];
                    const f32x4 x1 = acc[ai][0][m][n], x2 = acc[ai][1][m][n];
#pragma unroll
                    for (int j = 0; j < 4; ++j) {
                        const float c = bf_lo(w[j]) * sc, sn = bf_hi(w[j]) * sc;
                        o[0][n][j] = x1[j] * c - x2[j] * sn; o[1][n][j] = x2[j] * c + x1[j] * sn;
                        if (KSUM) { cs0[0][n][j] += o[0][n][j]; cs0[1][n][j] += o[1][n][j]; }
                    }
                }
                bf16_t* rowp = projb + (size_t)t * INW + colb;
#pragma unroll
                for (int b = 0; b < 2; ++b) {
                    u32x4 w; w.x = cvt_pk_bf16(o[b][0][0], o[b][0][1]); w.y = cvt_pk_bf16(o[b][0][2], o[b][0][3]); w.z = cvt_pk_bf16(o[b][1][0], o[b][1][1]); w.w = cvt_pk_bf16(o[b][1][2], o[b][1][3]);
                    *(u32x4*)(rowp + 64 * b) = w;
                }
            }
            __builtin_amdgcn_sched_barrier(0);
        }
        if (KSUM) {
#pragma unroll
            for (int b = 0; b < 2; ++b)
#pragma unroll
                for (int n = 0; n < 2; ++n)
#pragma unroll
                    for (int j = 0; j < 4; ++j) {
                        float v = cs0[b][n][j];
                        v += __shfl_xor(v, 1); v += __shfl_xor(v, 2); v += __shfl_xor(v, 4); v += __shfl_xor(v, 8);
                        cs0[b][n][j] = v;
                    }
            if (fr == 0) {
                float* kp = kpart + ((size_t)(u.pm * 2 + wr)) * 2048 + ksum_col;
#pragma unroll
                for (int b = 0; b < 2; ++b) {
                    *(f32x4*)(kp + 64 * b) = (f32x4){cs0[b][0][0], cs0[b][0][1], cs0[b][0][2], cs0[b][0][3]};
                    *(f32x4*)(kp + 64 * b + 4) = (f32x4){cs0[b][1][0], cs0[b][1][1], cs0[b][1][2], cs0[b][1][3]};
                }
            }
        }
    }
    template <int ACT>
    __device__ __forceinline__ void epi_act(const f32x4 (&acc)[2][2][4][2], const g8::Unit& u, int wr, int fr, int colb) const {
#pragma unroll
        for (int ai = 0; ai < 2; ++ai)
#pragma unroll
            for (int m = 0; m < 4; ++m) {
                const int t = 256 * u.pm + 128 * ai + 64 * wr + 16 * m + fr;
                bf16_t* rowp = projb + (size_t)t * INW + colb;
#pragma unroll
                for (int b = 0; b < 2; ++b) {
                    float o[8];
#pragma unroll
                    for (int n = 0; n < 2; ++n)
#pragma unroll
                        for (int j = 0; j < 4; ++j) { float x = F8_ ? acc[ai][b][m][n][j] * WSCALE_INV : acc[ai][b][m][n][j];
                            if (ACT != 0) asm volatile("" : "+v"(x));
                            o[4 * n + j] = ACT == 0 ? x : ACT == 1 ? x * fast_sigmoid(x) : fast_sigmoid(x); }
                    u32x4 w; w.x = cvt_pk_bf16(o[0], o[1]); w.y = cvt_pk_bf16(o[2], o[3]); w.z = cvt_pk_bf16(o[4], o[5]); w.w = cvt_pk_bf16(o[6], o[7]);
                    *(u32x4*)(rowp + 64 * b) = w;
                }
                if (ACT != 0) __builtin_amdgcn_sched_barrier(0);
            }
    }
    __device__ __forceinline__ void epi(const f32x4 (&acc)[2][2][4][2], const g8::Unit& u, int wr, int wc, int fr, int fq) const {
        const int pn = u.pn, head = wc >> 1, dd0 = 32 * (wc & 1) + 8 * fq;
        const int colb = 256 * pn + 128 * head + dd0;
        if (pn >= 4 && pn < 8) epi_rot<true, false>(acc, u, wr, fr, colb, dd0, 0);
        else if (pn < 4 || (pn >= 24 && pn < 32)) epi_rot<false, false>(acc, u, wr, fr, colb, dd0, 0);
        else if (pn >= 32 && pn < 40) epi_rot<false, true>(acc, u, wr, fr, colb, dd0, 256 * (pn - 32) + 128 * head + dd0);
        else if (pn < 16 || (pn >= 40 && pn < 48)) epi_act<0>(acc, u, wr, fr, colb);
        else if (pn < 24) epi_act<1>(acc, u, wr, fr, colb);
        else epi_act<2>(acc, u, wr, fr, colb);
    }
};

struct MKArgs {
    const float* x; const int* pos; const float* g_mix; const float* w_in; const float* w_reto; const float* w_mobao; const float* w_out;
    const float* g_ffn; const float* r_w; const float* r_b; const float* w_gu; const float* b_gu; const float* w_dn; const float* b_dn; const float* g_fin;
    float* out; char* ws;
};
struct P3Policy {
    const char* A0; const char* A1; const char* W0; const char* W1; const bf16_t* projb; float* tmp; bf16_t* merged; int G, c;
    static constexpr bool AVAR = false; static constexpr bool F8 = false;
    __device__ __forceinline__ int K() const { return D; }
    __device__ __forceinline__ bool next(int i, g8::Unit& u) const {
        int pm, pn; if (!g8::static_unit(i >> 1, G, c, T / 256, D / 256, pm, pn)) return false;
        const int sub = i & 1;
        u.pm = pm; u.pn = pn; u.e = 0; u.aux = sub; u.A = (sub ? A1 : A0) + (size_t)pm * 256 * D * 2; u.B = (sub ? W1 : W0) + (size_t)pn * 256 * D * 2; return true;
    }
    __device__ __forceinline__ unsigned aoff(const g8::Unit&, int h, int R) const { return (unsigned)((h * 128 + R) * D * 2); }
    __device__ __forceinline__ unsigned boff(int h, int R) const { return (unsigned)((128 * h + 32 * (R >> 5) + g8::perm32(R & 31)) * D * 2); }
    __device__ __forceinline__ void epi(const f32x4 (&acc)[2][2][4][2], const g8::Unit& u, int wr, int wc, int fr, int fq) const {
        const int sub = u.aux;
        bf16_t* tmpb = (bf16_t*)tmp;
        const int c00 = 256 * u.pn + 32 * wc + 8 * fq;
#pragma unroll
        for (int aim = 0; aim < 4; ++aim) {
            const int ai = aim >> 1, m0 = (aim & 1) * 2;
            u32x4 gw[2][2], tw[2][2];
#pragma unroll
            for (int mm = 0; mm < 2; ++mm)
#pragma unroll
                for (int bj = 0; bj < 2; ++bj) {
                    const size_t t = (size_t)(256 * u.pm + 128 * ai + 64 * wr + 16 * (m0 + mm) + fr);
                    gw[mm][bj] = *(const u32x4*)(projb + t * INW + C_GT + (sub ? D : 0) + c00 + 128 * bj);
                    if (sub) tw[mm][bj] = *(const u32x4*)(tmpb + t * D + c00 + 128 * bj);
                }
#pragma unroll
            for (int mm = 0; mm < 2; ++mm)
#pragma unroll
                for (int bj = 0; bj < 2; ++bj) {
                    const int m = m0 + mm;
                    const size_t t = (size_t)(256 * u.pm + 128 * ai + 64 * wr + 16 * m + fr);
                    const u32x4 g4 = gw[mm][bj];
                    float v[8];
#pragma unroll
                    for (int q = 0; q < 4; ++q) {
                        v[2 * q] = acc[ai][bj][m][q >> 1][(2 * q) & 3] * bf_lo(g4[q]);
                        v[2 * q + 1] = acc[ai][bj][m][q >> 1][(2 * q + 1) & 3] * bf_hi(g4[q]);
                    }
                    if (sub) {
                        const u32x4 p4 = tw[mm][bj];
#pragma unroll
                        for (int q = 0; q < 4; ++q) { v[2 * q] += bf_lo(p4[q]); v[2 * q + 1] += bf_hi(p4[q]); }
                    }
                    u32x4 w; w.x = cvt_pk_bf16(v[0], v[1]); w.y = cvt_pk_bf16(v[2], v[3]); w.z = cvt_pk_bf16(v[4], v[5]); w.w = cvt_pk_bf16(v[6], v[7]);
                    *(u32x4*)((sub ? merged : tmpb) + t * D + c00 + 128 * bj) = w;
                }
            __builtin_amdgcn_sched_barrier(0);
        }
    }
};
struct P4Policy {
    const char* A; const char* W; const float* x; float* xmid; int G, c;
    static constexpr bool AVAR = false; static constexpr bool F8 = false;
    __device__ __forceinline__ int K() const { return D; }
    __device__ __forceinline__ bool next(int i, g8::Unit& u) const {
        int pm, pn; if (!g8::static_unit(i, G, c, T / 256, D / 256, pm, pn)) return false;
        u.pm = pm; u.pn = pn; u.e = 0; u.aux = 0; u.A = A + (size_t)pm * 256 * D * 2; u.B = W + (size_t)pn * 256 * D * 2; return true;
    }
    __device__ __forceinline__ unsigned aoff(const g8::Unit&, int h, int R) const { return (unsigned)((h * 128 + R) * D * 2); }
    __device__ __forceinline__ unsigned boff(int h, int R) const { return (unsigned)((128 * h + R) * D * 2); }
    __device__ __forceinline__ void epi(const f32x4 (&acc)[2][2][4][2], const g8::Unit& u, int wr, int wc, int fr, int fq) const {
#pragma unroll
        for (int aim = 0; aim < 4; ++aim) {
            const int ai = aim >> 1, m0 = (aim & 1) * 2;
            f32x4 xv[2][2][2];
#pragma unroll
            for (int mm = 0; mm < 2; ++mm)
#pragma unroll
                for (int bj = 0; bj < 2; ++bj)
#pragma unroll
                    for (int n = 0; n < 2; ++n) {
                        const size_t o = (size_t)(256 * u.pm + 128 * ai + 64 * wr + 16 * (m0 + mm) + fr) * D + 256 * u.pn + 128 * bj + 32 * wc + 16 * n + 4 * fq;
                        xv[mm][bj][n] = *(const f32x4*)(x + o);
                    }
#pragma unroll
            for (int mm = 0; mm < 2; ++mm)
#pragma unroll
                for (int bj = 0; bj < 2; ++bj)
#pragma unroll
                    for (int n = 0; n < 2; ++n) {
                        const size_t o = (size_t)(256 * u.pm + 128 * ai + 64 * wr + 16 * (m0 + mm) + fr) * D + 256 * u.pn + 128 * bj + 32 * wc + 16 * n + 4 * fq;
                        *(f32x4*)(xmid + o) = xv[mm][bj][n] + acc[ai][bj][m0 + mm][n];
                    }
            __builtin_amdgcn_sched_barrier(0);
        }
    }
};
__device__ __forceinline__ void p5_router(const float* __restrict__ xmid, const float* __restrict__ g, const float* __restrict__ rw, const float* __restrict__ rb,
                                          bf16_t* __restrict__ h2b, int* __restrict__ topi, int* __restrict__ slot, int* __restrict__ counts,
                                          int* __restrict__ listc, float* __restrict__ rowwc, LAS float* lds  , int wg, int nwg) {
    typedef float f32x16 __attribute__((ext_vector_type(16)));
    const int tz = opaque_tid(), wid = __builtin_amdgcn_readfirstlane(tz >> 6), lane = tz & 63, i32 = lane & 31, kk = lane >> 5;
    LAS float* part = lds; LAS float* rs = lds + 8 * 32 * 32;
    LAS int* lcnt = (LAS int*)(rs + 32); LAS int* lbase = lcnt + 32; LAS int* asg_e = lbase + 32; LAS int* asg_r = asg_e + 128; LAS float* asg_w = (LAS float*)(asg_r + 128);
    if (tz < NE) lcnt[tz] = 0;
    __syncthreads();
    for (int tile = wg; tile < T / 32; tile += nwg) {
        const int t0 = tile * 32;
        f32x16 acc = {};
        const float* arow = xmid + (size_t)(t0 + i32) * D + 256 * wid + 4 * kk;
        const float* brow = rw + (size_t)(256 * wid + 4 * kk) * NE + i32;
        const float* gp = g + 256 * wid + 4 * kk;
#pragma unroll 4
        for (int q = 0; q < 32; ++q) {
            const float4 a4 = *(const float4*)(arow + 8 * q);
            const float4 g4 = *(const float4*)(gp + 8 * q);
            const float b0 = brow[(size_t)(8 * q + 0) * NE], b1 = brow[(size_t)(8 * q + 1) * NE], b2 = brow[(size_t)(8 * q + 2) * NE], b3 = brow[(size_t)(8 * q + 3) * NE];
            acc = __builtin_amdgcn_mfma_f32_32x32x2f32(a4.x, b0 * g4.x, acc, 0, 0, 0);
            acc = __builtin_amdgcn_mfma_f32_32x32x2f32(a4.y, b1 * g4.y, acc, 0, 0, 0);
            acc = __builtin_amdgcn_mfma_f32_32x32x2f32(a4.z, b2 * g4.z, acc, 0, 0, 0);
            acc = __builtin_amdgcn_mfma_f32_32x32x2f32(a4.w, b3 * g4.w, acc, 0, 0, 0);
        }
#pragma unroll
        for (int r = 0; r < 16; ++r) part[(wid * 32 + (r & 3) + 8 * (r >> 2) + 4 * kk) * 32 + i32] = acc[r];
#pragma unroll 1
        for (int rr = 0; rr < 4; ++rr) {
            const int row = 4 * wid + rr, t = t0 + row;
            const float4* xr = (const float4*)(xmid + (size_t)t * D);
            float4 v[8]; float ss = 0.f;
#pragma unroll
            for (int i = 0; i < 8; ++i) { v[i] = xr[lane + 64 * i]; ss += v[i].x * v[i].x + v[i].y * v[i].y + v[i].z * v[i].z + v[i].w * v[i].w; }
            ss = wave_sum(ss);
            const float r = rsqrtf(ss * (1.0f / D) + EPS);
#pragma unroll
            for (int i = 0; i < 8; ++i) {
                const float4 gg = ((const float4*)g)[lane + 64 * i];
                *(unsigned*)((unsigned char*)h2b + (size_t)t * D + (lane + 64 * i) * 4) = pk4_fp8(v[i].x * r * gg.x, v[i].y * r * gg.y, v[i].z * r * gg.z, v[i].w * r * gg.w);
            }
            if (lane == 0) rs[row] = r;
        }
        __syncthreads();
#pragma unroll 1
        for (int rr = 0; rr < 4; ++rr) {
            const int row = 4 * wid + rr, t = t0 + row;
            float s = 0.f;
#pragma unroll
            for (int w = 0; w < 8; ++w) s += part[(w * 32 + row) * 32 + i32];
            s = s * rs[row] + rb[i32];
            unsigned usedmask = 0u; float mx = 0.f, sum = 0.f, myex = 0.f; int myid = 0;
#pragma unroll
            for (int k = 0; k < 4; ++k) {
                float bv = -3.4e38f; int bi = 0;
                for (int j = 0; j < 32; ++j) { const float vv = __shfl(s, j); if (!((usedmask >> j) & 1u) && vv > bv) { bv = vv; bi = j; } }
                usedmask |= 1u << bi;
                if (k == 0) mx = bv;
                const float ex = __expf(bv - mx); sum += ex;
                if (lane == k) { myex = ex; myid = bi; }
            }
            if (lane < 4) {
                asg_e[row * 4 + lane] = myid; asg_w[row * 4 + lane] = myex / sum;
                asg_r[row * 4 + lane] = __hip_atomic_fetch_add(lcnt + myid, 1, __ATOMIC_RELAXED, __HIP_MEMORY_SCOPE_WORKGROUP);
            }
        }
        __syncthreads();
        if (tz < NE) { const int c = lcnt[tz]; lbase[tz] = c ? atomicAdd(&counts[tz * CNT_STRIDE], c) : 0; lcnt[tz] = 0; }
        __syncthreads();
        if (tz < 128) {
            const int e = asg_e[tz], sl = lbase[e] + asg_r[tz], t = t0 + (tz >> 2);
            topi[t * 4 + (tz & 3)] = e; slot[t * 4 + (tz & 3)] = sl;
            listc[(size_t)e * T + sl] = t; rowwc[(size_t)e * T + sl] = asg_w[tz];
        }
        __syncthreads();
    }
}
__device__ __forceinline__ void build_tile_table(const int* __restrict__ counts, LAS int* tab) {
    if (threadIdx.x == 0) { int acc = 0; for (int e = 0; e < NE; ++e) { tab[e] = acc; acc += (__hip_atomic_load(&counts[e * CNT_STRIDE], __ATOMIC_RELAXED, __HIP_MEMORY_SCOPE_AGENT) + 255) >> 8; } tab[NE] = acc; }
    __syncthreads();
}
__device__ __forceinline__ int tile_expert(const LAS int* tab, int mt) { int e = 0;
#pragma unroll 1
    for (int j = 1; j < NE; ++j) if (tab[j] <= mt) e = j;
    return e; }

__device__ __forceinline__ void build_unit_desc(const LAS int* tab, int c, LAS int* ud) {
    const int t = threadIdx.x;
    if (t < 32) {
        const int x = c & 7, y = c >> 3, i = t & 15;
        const int mt = t < 16 ? 16 * i + 8 * (x & 1) + (y & 7) : 32 * i + 8 * (x & 3) + (y & 7);
        ud[t] = mt < tab[NE] ? ((tile_expert(tab, mt) << 16) | mt) : -1;
    }
    __syncthreads();
}
struct P6Policy {
    const char* h2b; const char* WguT; const int* listc; const float* bgu; bf16_t* act; const LAS int* tab; const LAS int* ud; int G, c, i0, icnt;
    static constexpr bool AVAR = true;
    static constexpr bool F8 = true;
    __device__ __forceinline__ int K() const { return D / 2; }
    __device__ __forceinline__ bool next(int ii, g8::Unit& u) const {
        if (ii >= icnt) return false;
        const int i = i0 + ii;
        const int x = c & 7, y = c >> 3;
        if (i >= 16) return false;
        const int ent = ud[i]; if (ent < 0) return false;
        const int mt = ent & 0xffff, e = ent >> 16, pn = 4 * (x >> 1) + (y >> 3);
        u.pm = mt; u.pn = pn; u.e = e; u.aux = mt - tab[e];
        u.A = h2b; u.B = WguT + ((size_t)e * 2 * F + 128 * pn) * D; return true;
    }
    __device__ __forceinline__ unsigned aoff(const g8::Unit& u, int h, int R) const {
        const int tok = listc[(size_t)u.e * T + 256 * u.aux + 128 * h + R] & (T - 1);
        return (unsigned)tok * (unsigned)D;
    }
    __device__ __forceinline__ unsigned boff(int h, int R) const { return (unsigned)((F * h + 32 * (R >> 5) + g8::perm32(R & 31)) * D); }
    __device__ __forceinline__ void epi(const f32x4 (&acc)[2][2][4][2], const g8::Unit& u, int wr, int wc, int fr, int fq) const {
        const int c0 = 128 * u.pn + 32 * wc + 8 * fq;
        const float* bg = bgu + (size_t)u.e * 2 * F + c0;
        const f32x4 bg0 = *(const f32x4*)bg, bg1 = *(const f32x4*)(bg + 4), bu0 = *(const f32x4*)(bg + F), bu1 = *(const f32x4*)(bg + F + 4);
#pragma unroll
        for (int ai = 0; ai < 2; ++ai)
#pragma unroll
            for (int m = 0; m < 4; ++m) {
                const size_t row = (size_t)(256 * u.pm + 128 * ai + 64 * wr + 16 * m + fr);
                f32x4 o4[2];
#pragma unroll
                for (int n = 0; n < 2; ++n) {
                    f32x4 gt = acc[ai][0][m][n] * WSCALE_INV + (n ? bg1 : bg0), up = acc[ai][1][m][n] * WSCALE_INV + (n ? bu1 : bu0);
#pragma unroll
                    for (int j = 0; j < 4; ++j) { gt[j] = fminf(gt[j], 7.0f); up[j] = fminf(fmaxf(up[j], -7.0f), 7.0f); }
                    f32x4 e = gt * (-1.702f * 1.4426950408889634f);
#pragma unroll
                    for (int j = 0; j < 4; ++j) e[j] = __builtin_amdgcn_exp2f(e[j]);
                    e = e + 1.0f;
#pragma unroll
                    for (int j = 0; j < 4; ++j) e[j] = __builtin_amdgcn_rcpf(e[j]);
                    o4[n] = ((up + 1.0f) * gt) * e;
                }
                u32x2 w; w.x = pk4_fp8(o4[0][0], o4[0][1], o4[0][2], o4[0][3]); w.y = pk4_fp8(o4[1][0], o4[1][1], o4[1][2], o4[1][3]);
                *(u32x2*)((unsigned char*)act + row * F + c0) = w;
            }
    }
};
struct P7Policy {
    const char* actb; const char* WdnT; const float* rowwc; const float* bdn; bf16_t* yrow; const LAS int* tab; const LAS int* ud; int G, c;
    static constexpr bool AVAR = false;
    static constexpr bool F8 = true;
    __device__ __forceinline__ int K() const { return F / 2; }
    __device__ __forceinline__ bool next(int i, g8::Unit& u) const {
        const int x = c & 7, y = c >> 3;
        if (i >= 16) return false;
        const int ent = ud[16 + i]; if (ent < 0) return false;
        const int mt = ent & 0xffff, e = ent >> 16, pn = 4 * (x >> 2) + (y >> 3);
        u.pm = mt; u.pn = pn; u.e = e; u.aux = mt - tab[e];
        u.A = actb + (size_t)mt * 256 * F; u.B = WdnT + ((size_t)e * D + 256 * pn) * F; return true;
    }
    __device__ __forceinline__ unsigned aoff(const g8::Unit&, int h, int R) const { return (unsigned)((h * 128 + R) * F); }
    __device__ __forceinline__ unsigned boff(int h, int R) const { return (unsigned)((128 * h + 32 * (R >> 5) + g8::perm32(R & 31)) * F); }
    __device__ __forceinline__ void epi(const f32x4 (&acc)[2][2][4][2], const g8::Unit& u, int wr, int wc, int fr, int fq) const {
        float rw8[2][4]; f32x4 bb[2][2];
#pragma unroll
        for (int ai = 0; ai < 2; ++ai)
#pragma unroll
            for (int m = 0; m < 4; ++m) rw8[ai][m] = rowwc[(size_t)u.e * T + 256 * u.aux + 128 * ai + 64 * wr + 16 * m + fr];
#pragma unroll
        for (int bj = 0; bj < 2; ++bj) { const float* bp = bdn + (size_t)u.e * D + 256 * u.pn + 128 * bj + 32 * wc + 8 * fq; bb[bj][0] = *(const f32x4*)bp; bb[bj][1] = *(const f32x4*)(bp + 4); }
#pragma unroll
        for (int ai = 0; ai < 2; ++ai)
#pragma unroll
            for (int m = 0; m < 4; ++m) {
                const int lr = 128 * ai + 64 * wr + 16 * m + fr;
                const float rwt = rw8[ai][m];
                const size_t row = (size_t)(256 * u.pm + lr);
#pragma unroll
                for (int bj = 0; bj < 2; ++bj) {
                    const int c0 = 256 * u.pn + 128 * bj + 32 * wc + 8 * fq;
                    const f32x4 b0 = bb[bj][0], b1 = bb[bj][1];
                    const float rws = rwt * YSCALE;
                    const f32x4 v0 = (acc[ai][bj][m][0] * WSCALE_INV + b0) * rws, v1 = (acc[ai][bj][m][1] * WSCALE_INV + b1) * rws;
                    u32x2 w; w.x = pk4_fp8(v0[0], v0[1], v0[2], v0[3]); w.y = pk4_fp8(v1[0], v1[1], v1[2], v1[3]);
                    *(u32x2*)((unsigned char*)yrow + row * D + c0) = w;
                }
            }
    }
};
__device__ __forceinline__ void p8_final(const float* __restrict__ xmid, const bf16_t* __restrict__ yrow, const int* __restrict__ topi, const int* __restrict__ slot,
                                         const LAS int* tab, const float* __restrict__ g, float* __restrict__ out, int wg, int nwg) {
    const int tz = opaque_tid(), wid = tz >> 6, lane = tz & 63;
    for (int t = wg * 8 + wid; t < T; t += nwg * 8) {
        const float4* xr = (const float4*)(xmid + (size_t)t * D);
        float4 v[8];
#pragma unroll
        for (int i = 0; i < 8; ++i) v[i] = xr[lane + 64 * i];
#pragma unroll
        for (int k = 0; k < 4; ++k) {
            const int e = topi[t * 4 + k], sl = slot[t * 4 + k];
            const unsigned char* yr = (const unsigned char*)yrow + ((size_t)tab[e] * 256 + sl) * D;
#pragma unroll
            for (int i = 0; i < 8; ++i) {
                const unsigned w = *(const unsigned*)(yr + (lane + 64 * i) * 4);
                const auto lo = __builtin_amdgcn_cvt_pk_f32_fp8((int)w, false), hi = __builtin_amdgcn_cvt_pk_f32_fp8((int)w, true);
                v[i].x += lo[0] * YSCALE_INV; v[i].y += lo[1] * YSCALE_INV; v[i].z += hi[0] * YSCALE_INV; v[i].w += hi[1] * YSCALE_INV;
            }
        }
        float ss = 0.f;
#pragma unroll
        for (int i = 0; i < 8; ++i) ss += v[i].x * v[i].x + v[i].y * v[i].y + v[i].z * v[i].z + v[i].w * v[i].w;
        ss = wave_sum(ss);
        const float r = rsqrtf(ss * (1.0f / D) + EPS);
#pragma unroll
        for (int i = 0; i < 8; ++i) {
            const float4 gg = ((const float4*)g)[lane + 64 * i];
            float4 o; o.x = v[i].x * r * gg.x; o.y = v[i].y * r * gg.y; o.z = v[i].z * r * gg.z; o.w = v[i].w * r * gg.w;
            ((float4*)(out + (size_t)t * D))[lane + 64 * i] = o;
        }
    }
}

namespace mb {
using s16x4  = __attribute__((ext_vector_type(4))) short;
using f32x16 = __attribute__((ext_vector_type(16))) float;
constexpr int KVBLK = 64;
constexpr float SCALE = 0.088388347648318440f;
constexpr float THR = 8.f;
constexpr float NEG = -1e30f;
constexpr size_t SHM_V = KVBLK * 128 * 2, SHM_K = KVBLK * 128 * 2;
constexpr int NB = 4;
constexpr int OFF_K = NB * SHM_V, OFF_WS = NB * SHM_V + NB * SHM_K, OFF_KM = OFF_WS + 8 * 64 * 4;
constexpr int LDS_NEED = OFF_KM + 8 * 128 * 4;
#define MB_KSWZ(row, colB) ((row) * 256 + ((colB) ^ (((row) & 7) << 4)))
#define MB_SBAR() __builtin_amdgcn_sched_barrier(0)
__device__ __forceinline__ int crow(int r, int hi) { return (r & 3) + 8 * (r >> 2) + 4 * hi; }

__device__ __forceinline__ void partialSM(f32x16& p0, f32x16& p1, float& m_reg, float& mn, float& alpha, bool diag, bool keep, int lim) {
  typedef float f32x2_t __attribute__((ext_vector_type(2)));
  constexpr float C = SCALE * 1.4426950408889634f;
  if (diag) {
#pragma unroll
    for (int r = 0; r < 16; ++r) { const int kk = (r & 3) + 8 * (r >> 2); p0[r] = (kk <= lim) ? p0[r] : NEG; p1[r] = (kk + 32 <= lim) ? p1[r] : NEG; }
  }
  float pmax = p0[0];
#pragma unroll
  for (int r = 1; r < 16; ++r) pmax = fmaxf(pmax, p0[r]);
#pragma unroll
  for (int r = 0; r < 16; ++r) pmax = fmaxf(pmax, p1[r]);
  { auto rr = __builtin_amdgcn_permlane32_swap(__float_as_uint(pmax), __float_as_uint(pmax), false, false);
    pmax = fmaxf(__uint_as_float(rr[0]), __uint_as_float(rr[1])); }
  pmax = keep ? pmax : NEG;
  if (__builtin_expect(__all(pmax - m_reg <= THR / SCALE), 1)) { mn = m_reg; alpha = 1.f; }
  else { mn = fmaxf(m_reg, pmax); alpha = __builtin_amdgcn_exp2f((m_reg - mn) * C); m_reg = mn; }
  const float mnC = keep ? -mn * C : NEG;
  const f32x2_t c2 = {C, C}, m2 = {mnC, mnC};
#pragma unroll
  for (int r = 0; r < 16; r += 2) { f32x2_t v = {p0[r], p0[r + 1]}; v = __builtin_elementwise_fma(v, c2, m2); p0[r] = v[0]; p0[r + 1] = v[1]; }
#pragma unroll
  for (int r = 0; r < 16; r += 2) { f32x2_t v = {p1[r], p1[r + 1]}; v = __builtin_elementwise_fma(v, c2, m2); p1[r] = v[0]; p1[r + 1] = v[1]; }
#pragma unroll
  for (int r = 0; r < 16; ++r) p0[r] = __builtin_amdgcn_exp2f(p0[r]);
}
__device__ __forceinline__ void finishSM(f32x16& p0, f32x16& p1, float alpha, float& l_reg, bf16x8& pa0, bf16x8& pa1, bf16x8& pa2, bf16x8& pa3) {
  typedef float f32x2_t __attribute__((ext_vector_type(2)));
#pragma unroll
  for (int r = 0; r < 16; ++r) p1[r] = __builtin_amdgcn_exp2f(p1[r]);
  f32x2_t s2 = {0.f, 0.f};
#pragma unroll
  for (int r = 0; r < 16; r += 2) { const f32x2_t v = {p0[r], p0[r + 1]}; s2 += v; }
#pragma unroll
  for (int r = 0; r < 16; r += 2) { const f32x2_t v = {p1[r], p1[r + 1]}; s2 += v; }
  float ps = s2[0] + s2[1];
  { auto rr = __builtin_amdgcn_permlane32_swap(__float_as_uint(ps), __float_as_uint(ps), false, false);
    ps = __uint_as_float(rr[0]) + __uint_as_float(rr[1]); }
  l_reg = l_reg * alpha + ps;
#define MB_PK4(P, BASE, OUT) do { unsigned a0 = cvt_pk_bf16(P[BASE + 0], P[BASE + 1]), a1 = cvt_pk_bf16(P[BASE + 2], P[BASE + 3]);   \
    unsigned b0 = cvt_pk_bf16(P[BASE + 4], P[BASE + 5]), b1 = cvt_pk_bf16(P[BASE + 6], P[BASE + 7]);                              \
    auto r0 = __builtin_amdgcn_permlane32_swap(a0, b0, false, false); auto r1 = __builtin_amdgcn_permlane32_swap(a1, b1, false, false); \
    u32x4 w = {r0[0], r1[0], r0[1], r1[1]}; OUT = *reinterpret_cast<bf16x8*>(&w); } while (0)
  MB_PK4(p0, 0, pa0); MB_PK4(p0, 8, pa1); MB_PK4(p1, 0, pa2); MB_PK4(p1, 8, pa3);
#undef MB_PK4
}
__device__ __forceinline__ void qkt(f32x16& p0, f32x16& p1, const LAS char* Ks, const bf16x8* qr, int r32, int hi) {
  p0 = f32x16{}; p1 = f32x16{};
#pragma unroll
  for (int d0 = 0; d0 < 8; ++d0) { int cb = (d0 * 16 + hi * 8) * 2;
    bf16x8 b0 = *reinterpret_cast<const LAS bf16x8*>(Ks + MB_KSWZ(r32, cb));
    bf16x8 b1 = *reinterpret_cast<const LAS bf16x8*>(Ks + MB_KSWZ(32 + r32, cb));
    p0 = __builtin_amdgcn_mfma_f32_32x32x16_bf16(b0, qr[d0], p0, 0, 0, 0);
    p1 = __builtin_amdgcn_mfma_f32_32x32x16_bf16(b1, qr[d0], p1, 0, 0, 0); }
}
__device__ __forceinline__ int v_st(int k, int c) { const int kk = (k & ~0xC) | ((k & 4) << 1) | ((k & 8) >> 1); return ((kk >> 3) * 4 + (c >> 5)) * 512 + ((kk & 7) * 32 + (c & 31)) * 2; }
__device__ __forceinline__ int v_rd_base(int lane) { return ((lane & 3) << 3) | (((lane >> 2) & 3) << 6) | (((lane >> 4) & 1) << 5) | (((lane >> 5) & 1) << 8); }
constexpr int v_rd_off(int d0, int ks, int half) { return d0 * 512 + ks * 4096 + half * 2048; }
template <int OFF> __device__ __forceinline__ s16x4 tr_read(int vb) {
  s16x4 r; asm volatile("ds_read_b64_tr_b16 %0, %1 offset:%2" : "=&v"(r) : "v"(vb), "i"(OFF) : "memory"); return r;
}
template <int D0> __device__ __forceinline__ void pv_one(f32x16& od, int vb, bf16x8 pa0, bf16x8 pa1, bf16x8 pa2, bf16x8 pa3) {
  const s16x4 l0 = tr_read<v_rd_off(D0, 0, 0)>(vb), h0 = tr_read<v_rd_off(D0, 0, 1)>(vb), l1 = tr_read<v_rd_off(D0, 1, 0)>(vb), h1 = tr_read<v_rd_off(D0, 1, 1)>(vb);
  const s16x4 l2 = tr_read<v_rd_off(D0, 2, 0)>(vb), h2 = tr_read<v_rd_off(D0, 2, 1)>(vb), l3 = tr_read<v_rd_off(D0, 3, 0)>(vb), h3 = tr_read<v_rd_off(D0, 3, 1)>(vb);
  asm volatile("s_waitcnt lgkmcnt(0)" ::: "memory"); MB_SBAR();
#define MB_PK(L, H) (bf16x8){L[0], L[1], L[2], L[3], H[0], H[1], H[2], H[3]}
  od = __builtin_amdgcn_mfma_f32_32x32x16_bf16(pa0, MB_PK(l0, h0), od, 0, 0, 0);
  od = __builtin_amdgcn_mfma_f32_32x32x16_bf16(pa1, MB_PK(l1, h1), od, 0, 0, 0);
  od = __builtin_amdgcn_mfma_f32_32x32x16_bf16(pa2, MB_PK(l2, h2), od, 0, 0, 0);
  od = __builtin_amdgcn_mfma_f32_32x32x16_bf16(pa3, MB_PK(l3, h3), od, 0, 0, 0);
#undef MB_PK
}
__device__ __forceinline__ void pv_d0(f32x16* o, int vb, bf16x8 pa0, bf16x8 pa1, bf16x8 pa2, bf16x8 pa3) {
  pv_one<0>(o[0], vb, pa0, pa1, pa2, pa3); pv_one<1>(o[1], vb, pa0, pa1, pa2, pa3); pv_one<2>(o[2], vb, pa0, pa1, pa2, pa3); pv_one<3>(o[3], vb, pa0, pa1, pa2, pa3);
}

__device__ __forceinline__ void moba_item(const bf16_t* __restrict__ projb, const float* __restrict__ kpart, bf16_t* __restrict__ omoba, int b, int h, int cur, LAS char* lds) {
  constexpr long LD = INW;
  const int tid = opaque_tid(), wid = tid >> 6, lane = tid & 63, r32 = lane & 31, hi = lane >> 5;
  const bf16_t* Qb = projb + ((long)(b * S + cur * MBLK)) * LD + C_MQ + h * 128;
  const bf16_t* Kh = projb + ((long)(b * S)) * LD + C_MK + h * 128;
  const bf16_t* Vh = projb + ((long)(b * S)) * LD + C_MV + h * 128;
  LAS char* V_lds = lds; LAS char* K_lds = lds + OFF_K;
  LAS float* wsl = (LAS float*)(lds + OFF_WS) + wid * 64; LAS float* li_l = wsl; LAS float* al_l = wsl + 32;
  LAS float* km = (LAS float*)(lds + OFF_KM);
  __syncthreads();
  for (int i = tid; i < cur * 128; i += 512) { const int j = i >> 7, d = i & 127; const int pm = b * 8 + j;
    km[i] = (kpart[(size_t)(pm * 2) * 2048 + h * 128 + d] + kpart[(size_t)(pm * 2 + 1) * 2048 + h * 128 + d]) * (1.0f / MBLK); }
  float m_reg = -1e30f, l_reg = 0; f32x16 o[4] = {}; bf16x8 qr[8];
  const bf16_t* Qw = Qb + (long)(wid * 32 + r32) * LD + hi * 8;
#pragma unroll
  for (int d0 = 0; d0 < 8; ++d0) qr[d0] = *reinterpret_cast<const bf16x8*>(Qw + d0 * 16);
  const int widu = __builtin_amdgcn_readfirstlane(wid);
  const int krow = wid * 8 + (lane >> 4);
  const int koff0 = krow * (int)(LD * 2) + (((lane & 15) ^ (krow & 7)) << 4), koff1 = (krow + 4) * (int)(LD * 2) + (((lane & 15) ^ ((krow + 4) & 7)) << 4);
  const int kkv = wid * 8 + ((lane >> 2) & 7), kpv = (kkv & ~0xC) | ((kkv & 4) << 1) | ((kkv & 8) >> 1);
  const int voff0 = kpv * (int)(LD * 2) + (((lane >> 5) * 32 + (lane & 3) * 8) << 1), voff1 = voff0 + 128;
#define MB_K0(t) ((((t) >> 2) == 0 ? cur : ((t) >> 2) - 1) * MBLK + ((t) & 3) * KVBLK)
#define MB_DMA(t) do { const int t_ = (t); const long k0_ = MB_K0(t_); const int bb_ = t_ & 3;                                           \
    const char* kg_ = (const char*)(Kh + k0_ * LD); const char* vg_ = (const char*)(Vh + k0_ * LD);                                       \
    LAS char* kd_ = K_lds + bb_ * SHM_K + widu * 2048; LAS char* vd_ = V_lds + bb_ * SHM_V + widu * 2048;                                 \
    __builtin_amdgcn_global_load_lds((const unsigned*)(kg_ + koff0), (LAS unsigned*)kd_, 16, 0, 0);                                       \
    __builtin_amdgcn_global_load_lds((const unsigned*)(kg_ + koff1), (LAS unsigned*)(kd_ + 1024), 16, 0, 0);                              \
    __builtin_amdgcn_global_load_lds((const unsigned*)(vg_ + voff0), (LAS unsigned*)vd_, 16, 0, 0);                                       \
    __builtin_amdgcn_global_load_lds((const unsigned*)(vg_ + voff1), (LAS unsigned*)(vd_ + 1024), 16, 0, 0); } while (0)
  MB_DMA(0); MB_DMA(1); MB_DMA(2);
  __syncthreads();
  unsigned selmask = 0u;
  if (cur > 0) {
    float g[7];
#pragma unroll
    for (int j = 0; j < 7; ++j) {
      float s = 0.f;
      if (j < cur) {
#pragma unroll
        for (int d0 = 0; d0 < 8; ++d0) {
          const f32x4 k0 = *(const LAS f32x4*)(km + j * 128 + d0 * 16 + hi * 8), k1 = *(const LAS f32x4*)(km + j * 128 + d0 * 16 + hi * 8 + 4);
          const bf16x8 q = qr[d0];
          s += __uint_as_float(((unsigned)(unsigned short)q[0]) << 16) * k0[0] + __uint_as_float(((unsigned)(unsigned short)q[1]) << 16) * k0[1]
             + __uint_as_float(((unsigned)(unsigned short)q[2]) << 16) * k0[2] + __uint_as_float(((unsigned)(unsigned short)q[3]) << 16) * k0[3]
             + __uint_as_float(((unsigned)(unsigned short)q[4]) << 16) * k1[0] + __uint_as_float(((unsigned)(unsigned short)q[5]) << 16) * k1[1]
             + __uint_as_float(((unsigned)(unsigned short)q[6]) << 16) * k1[2] + __uint_as_float(((unsigned)(unsigned short)q[7]) << 16) * k1[3];
        }
        s += __shfl_xor(s, 32);
      } else s = -3.0e38f;
      g[j] = s;
    }
#pragma unroll
    for (int j = 0; j < 7; ++j) {
      int rank = 0;
#pragma unroll
      for (int i = 0; i < 7; ++i) if (i != j) rank += (g[i] > g[j] || (g[i] == g[j] && i < j)) ? 1 : 0;
      if (j < cur && rank < 3) selmask |= 1u << j;
    }
  }
  const int qi = wid * 32 + r32;
  const int vb0 = (int)(uintptr_t)V_lds + v_rd_base(lane);
  const int NT = 4 * (cur + 1);
#define MB_WAIT(more) do { if (more) asm volatile("s_waitcnt vmcnt(4)" ::: "memory"); else asm volatile("s_waitcnt vmcnt(0)" ::: "memory"); } while (0)
#define MB_RESC(a) do { if (__any((a) < 1.f)) { if (hi == 0) al_l[r32] = (a); asm volatile("s_waitcnt lgkmcnt(0)" ::: "memory"); \
    _Pragma("unroll") for (int d = 0; d < 4; ++d) _Pragma("unroll") for (int r = 0; r < 16; ++r) o[d][r] *= al_l[crow(r, hi)]; } } while (0)
#define MB_MASKP(t, DG, KP, LM) const bool DG = ((t) >> 2) == 0; const bool KP = DG ? true : (((selmask >> (((t) >> 2) - 1)) & 1u) != 0u); const int LM = qi - ((t) & 3) * KVBLK - 4 * hi;
  f32x16 pA0, pA1, pB0, pB1; float mnA, mnB, alA, alB; bf16x8 pa0, pa1, pa2, pa3;
  asm volatile("s_waitcnt vmcnt(0)" ::: "memory"); __syncthreads();
  { MB_MASKP(0, dg, kp, lm); qkt(pA0, pA1, K_lds, qr, r32, hi); partialSM(pA0, pA1, m_reg, mnA, alA, dg, kp, lm); }
  const int wact = widu >> 1;
#define MB_ACT(t) ((t) > 3 || (t) <= wact)
  for (int j = 1; j + 1 < NT; j += 2) {
    const bool more1 = j + 2 < NT, more2 = j + 3 < NT;
    const bool actP = MB_ACT(j - 1), actC = MB_ACT(j), actN = MB_ACT(j + 1);
    if (more1) MB_DMA(j + 2);
    MB_SBAR(); if (actC) qkt(pB0, pB1, K_lds + (j & 3) * SHM_K, qr, r32, hi);
    if (actP) finishSM(pA0, pA1, alA, l_reg, pa0, pa1, pa2, pa3);
    MB_SBAR();
    if (actP) pv_d0(o, vb0 + ((j - 1) & 3) * (int)SHM_V, pa0, pa1, pa2, pa3);
    if (actC) { MB_MASKP(j, dg, kp, lm); partialSM(pB0, pB1, m_reg, mnB, alB, dg, kp, lm); MB_RESC(alB); }
    MB_WAIT(more1); __syncthreads();
    if (more2) MB_DMA(j + 3);
    MB_SBAR(); if (actN) qkt(pA0, pA1, K_lds + ((j + 1) & 3) * SHM_K, qr, r32, hi);
    if (actC) finishSM(pB0, pB1, alB, l_reg, pa0, pa1, pa2, pa3);
    MB_SBAR();
    if (actC) pv_d0(o, vb0 + (j & 3) * (int)SHM_V, pa0, pa1, pa2, pa3);
    if (actN) { MB_MASKP(j + 1, dg, kp, lm); partialSM(pA0, pA1, m_reg, mnA, alA, dg, kp, lm); MB_RESC(alA); }
    MB_WAIT(more2); __syncthreads();
  }
  {
    const bool actP = MB_ACT(NT - 2), actC = MB_ACT(NT - 1);
    MB_SBAR(); if (actC) qkt(pB0, pB1, K_lds + ((NT - 1) & 3) * SHM_K, qr, r32, hi);
    if (actP) finishSM(pA0, pA1, alA, l_reg, pa0, pa1, pa2, pa3);
    MB_SBAR();
    if (actP) pv_d0(o, vb0 + ((NT - 2) & 3) * (int)SHM_V, pa0, pa1, pa2, pa3);
    if (actC) {
      { MB_MASKP(NT - 1, dg, kp, lm); partialSM(pB0, pB1, m_reg, mnB, alB, dg, kp, lm); }
      MB_RESC(alB);
      finishSM(pB0, pB1, alB, l_reg, pa0, pa1, pa2, pa3); MB_SBAR();
      pv_d0(o, vb0 + ((NT - 1) & 3) * (int)SHM_V, pa0, pa1, pa2, pa3);
    }
  }
#undef MB_ACT
  if (hi == 0) li_l[r32] = l_reg; asm volatile("s_waitcnt lgkmcnt(0)" ::: "memory");
  float rli[16];
#pragma unroll
  for (int r = 0; r < 16; ++r) rli[r] = __builtin_amdgcn_rcpf(li_l[crow(r, hi)]);
  { const int t2 = opaque_tid(), w2 = t2 >> 6, r2 = t2 & 31, h2 = (t2 >> 5) & 1;
    bf16_t* Ow = omoba + ((long)(b * S + cur * MBLK + w2 * 32)) * D + h * 128 + r2;
#pragma unroll
    for (int r = 0; r < 16; ++r) { const int orow = crow(r, h2);
#pragma unroll
      for (int d0 = 0; d0 < 4; ++d0) { const float v = o[d0][r] * rli[r]; Ow[(long)orow * D + d0 * 32] = (bf16_t)(cvt_pk_bf16(v, v) & 0xffffu); } } }
#undef MB_K0
#undef MB_DMA
#undef MB_WAIT
#undef MB_RESC
#undef MB_MASKP
}
}

namespace rt {
using mb::f32x16; using mb::s16x4;
constexpr int RP = 272, R0 = 0, R1 = 34816, R2 = 69632, R3 = 104448;
constexpr int OPITCH = 528;
__device__ __forceinline__ bf16x8 scale8(bf16x8 v, float f) {
    u32x4 w;
    w.x = cvt_pk_bf16(__uint_as_float(((unsigned)(unsigned short)v[0]) << 16) * f, __uint_as_float(((unsigned)(unsigned short)v[1]) << 16) * f);
    w.y = cvt_pk_bf16(__uint_as_float(((unsigned)(unsigned short)v[2]) << 16) * f, __uint_as_float(((unsigned)(unsigned short)v[3]) << 16) * f);
    w.z = cvt_pk_bf16(__uint_as_float(((unsigned)(unsigned short)v[4]) << 16) * f, __uint_as_float(((unsigned)(unsigned short)v[5]) << 16) * f);
    w.w = cvt_pk_bf16(__uint_as_float(((unsigned)(unsigned short)v[6]) << 16) * f, __uint_as_float(((unsigned)(unsigned short)v[7]) << 16) * f);
    return *reinterpret_cast<bf16x8*>(&w);
}
#define RT_PK(L, H) (bf16x8){L[0], L[1], L[2], L[3], H[0], H[1], H[2], H[3]}
template <int TH, int KS, bool FULL>
__device__ __forceinline__ void cd_step(f32x16 (&O)[4], f32x16 (&Z)[4], LAS char* lds, int vbase, int ktbase, int r32, int hi) {
    constexpr int s = TH * 4 + KS;
    const s16x4 vl = mb::tr_read<mb::v_rd_off(0, KS, 0)>(vbase), vh = mb::tr_read<mb::v_rd_off(0, KS, 1)>(vbase);
    const s16x4 k0l = mb::tr_read<mb::v_rd_off(0, KS, 0)>(ktbase), k0h = mb::tr_read<mb::v_rd_off(0, KS, 1)>(ktbase);
    const s16x4 k1l = mb::tr_read<mb::v_rd_off(1, KS, 0)>(ktbase), k1h = mb::tr_read<mb::v_rd_off(1, KS, 1)>(ktbase);
    const s16x4 k2l = mb::tr_read<mb::v_rd_off(2, KS, 0)>(ktbase), k2h = mb::tr_read<mb::v_rd_off(2, KS, 1)>(ktbase);
    const s16x4 k3l = mb::tr_read<mb::v_rd_off(3, KS, 0)>(ktbase), k3h = mb::tr_read<mb::v_rd_off(3, KS, 1)>(ktbase);
    bf16x8 sa[4];
    if constexpr (FULL) {
#pragma unroll
        for (int I = s >> 1; I < 4; ++I) sa[I] = *reinterpret_cast<const LAS bf16x8*>(lds + R2 + ((32 * I + r32) * RP + (16 * s + 8 * hi) * 2));
    }
    asm volatile("s_waitcnt lgkmcnt(0)" ::: "memory"); MB_SBAR();
    const bf16x8 bv = RT_PK(vl, vh);
    if constexpr (FULL) {
#pragma unroll
        for (int I = s >> 1; I < 4; ++I) O[I] = __builtin_amdgcn_mfma_f32_32x32x16_bf16(sa[I], bv, O[I], 0, 0, 0);
    }
    Z[0] = __builtin_amdgcn_mfma_f32_32x32x16_bf16(RT_PK(k0l, k0h), bv, Z[0], 0, 0, 0);
    Z[1] = __builtin_amdgcn_mfma_f32_32x32x16_bf16(RT_PK(k1l, k1h), bv, Z[1], 0, 0, 0);
    Z[2] = __builtin_amdgcn_mfma_f32_32x32x16_bf16(RT_PK(k2l, k2h), bv, Z[2], 0, 0, 0);
    Z[3] = __builtin_amdgcn_mfma_f32_32x32x16_bf16(RT_PK(k3l, k3h), bv, Z[3], 0, 0, 0);
}
#define RT_IDS(tz, lane, r32, hi, sr, sc) int tz = threadIdx.x; asm volatile("" : "+v"(tz)); const int lane = tz & 63, r32 = lane & 31, hi = lane >> 5, sr = tz >> 4, sc = (tz & 15) * 8; (void)sr; (void)sc; (void)r32; (void)hi;
struct Pf { bf16x8 k[4], q[4], v[8]; };
__device__ __forceinline__ void pf_load_k(Pf& pf, const bf16_t* __restrict__ Kg, int t0) { constexpr long LD = INW; RT_IDS(tz, lane, r32, hi, sr, sc)
#pragma unroll
    for (int i = 0; i < 4; ++i) pf.k[i] = *reinterpret_cast<const bf16x8*>(Kg + (long)(t0 + sr + 32 * i) * LD + sc); }
__device__ __forceinline__ void pf_load_q(Pf& pf, const bf16_t* __restrict__ Qg, int t0) { constexpr long LD = INW; RT_IDS(tz, lane, r32, hi, sr, sc)
#pragma unroll
    for (int i = 0; i < 4; ++i) pf.q[i] = *reinterpret_cast<const bf16x8*>(Qg + (long)(t0 + sr + 32 * i) * LD + sc); }
__device__ __forceinline__ void pf_load_v(Pf& pf, const bf16_t* __restrict__ Vg, int t0) { constexpr long LD = INW; RT_IDS(tz, lane, r32, hi, sr, sc)
#pragma unroll
    for (int i = 0; i < 4; ++i)
#pragma unroll
        for (int q = 0; q < 2; ++q) pf.v[2 * i + q] = *reinterpret_cast<const bf16x8*>(Vg + (long)(t0 + sr + 32 * i) * LD + 128 * q + sc); }
__device__ __forceinline__ void pf_write_v(const Pf& pf, LAS char* lds) { RT_IDS(tz, lane, r32, hi, sr, sc)
#pragma unroll
    for (int i = 0; i < 4; ++i) { const int row = sr + 32 * i;
#pragma unroll
        for (int q = 0; q < 2; ++q) *(LAS bf16x8*)(lds + ((row >> 6) ? R1 : R0) + q * 16384 + mb::v_st(row & 63, sc)) = pf.v[2 * i + q]; } }
template <bool full>
__device__ __forceinline__ void ret_chunk(f32x16 (&Z)[4], Pf& pf, const bf16_t* __restrict__ Qg, const bf16_t* __restrict__ Kg, const bf16_t* __restrict__ Vg, const bf16_t* __restrict__ Gg,
                                          bf16_t* __restrict__ oretb, int b, int h, int c, int nxt, float lg2, float cd, int wid, LAS char* lds) {
    constexpr long LD = INW;
    const int hd = wid >> 2, d0 = wid & 3;
    {
        const int t0 = c * 128;
        f32x16 O[4] = {};
        __syncthreads();

        {
            RT_IDS(tz, lane, r32, hi, sr, sc)
#pragma unroll
            for (int i = 0; i < 4; ++i) {
                const int row = sr + 32 * i;
                const bf16x8 ks = scale8(pf.k[i], exp2f(-(float)row * lg2));
                *(LAS bf16x8*)(lds + R3 + (row >> 6) * 16384 + mb::v_st(row & 63, sc)) = ks;
                if constexpr (full) {
                    *(LAS bf16x8*)(lds + R0 + (row * RP + sc * 2)) = ks;
                    *(LAS bf16x8*)(lds + R1 + (row * RP + sc * 2)) = scale8(pf.q[i], exp2f((float)row * lg2));
                }
            }
        }
        if constexpr (full) pf_load_v(pf, Vg, t0);
        else {
            pf_write_v(pf, lds);
            if (nxt) pf_load_k(pf, Kg, t0 + 128);
            if (nxt == 1) pf_load_v(pf, Vg, t0 + 128);
            if (nxt == 2) pf_load_q(pf, Qg, t0 + 128);
        }
#pragma unroll
        for (int d = 0; d < 4; ++d)
#pragma unroll
            for (int r = 0; r < 16; ++r) Z[d][r] *= cd;
        if constexpr (full) {
            __syncthreads();
            {
                RT_IDS(tz, lane, r32, hi, sr, sc)
                for (int ti = wid; ti < 10; ti += 8) {
                    int I, J;
                    if (ti == 0) { I = 0; J = 0; } else if (ti < 3) { I = 1; J = ti - 1; } else if (ti < 6) { I = 2; J = ti - 3; } else { I = 3; J = ti - 6; }
                    f32x16 sacc = {};
                    const LAS char* kap = lds + R0 + (32 * J + r32) * RP + 16 * hi;
                    const LAS char* qbp = lds + R1 + (32 * I + r32) * RP + 16 * hi;
#pragma unroll
                    for (int s = 0; s < 8; ++s) {
                        const bf16x8 ka = *reinterpret_cast<const LAS bf16x8*>(kap + 32 * s);
                        const bf16x8 qb = *reinterpret_cast<const LAS bf16x8*>(qbp + 32 * s);
                        sacc = __builtin_amdgcn_mfma_f32_32x32x16_bf16(ka, qb, sacc, 0, 0, 0);
                    }
                    LAS char* wp = lds + R2 + (32 * I + r32) * RP + (32 * J + 4 * hi) * 2;
                    const int lim = (I == J) ? r32 - 4 * hi : 1000;
#pragma unroll
                    for (int g = 0; g < 4; ++g) {
                        float v[4];
#pragma unroll
                        for (int q = 0; q < 4; ++q) v[q] = (8 * g + q > lim) ? 0.f : sacc[4 * g + q];
                        u32x2 w; w.x = cvt_pk_bf16(v[0], v[1]); w.y = cvt_pk_bf16(v[2], v[3]);
                        *(LAS u32x2*)(wp + 16 * g) = w;
                    }
                }
            }
            {
                RT_IDS(tz, lane, r32, hi, sr, sc)
                const LAS char* qp = lds + R1 + r32 * RP + 8 * hi;
#pragma unroll
                for (int s = 0; s < 8; ++s) {
                    const int dkt = s >> 1, sub = s & 1;
                    u32x4 zw;
                    zw.x = cvt_pk_bf16(Z[dkt][8 * sub + 0], Z[dkt][8 * sub + 1]); zw.y = cvt_pk_bf16(Z[dkt][8 * sub + 2], Z[dkt][8 * sub + 3]);
                    zw.z = cvt_pk_bf16(Z[dkt][8 * sub + 4], Z[dkt][8 * sub + 5]); zw.w = cvt_pk_bf16(Z[dkt][8 * sub + 6], Z[dkt][8 * sub + 7]);
                    const bf16x8 bz = *reinterpret_cast<bf16x8*>(&zw);
#pragma unroll
                    for (int I = 0; I < 4; ++I) {
                        const u32x2 a0 = *(const LAS u32x2*)(qp + 32 * I * RP + 32 * s);
                        const u32x2 a1 = *(const LAS u32x2*)(qp + 32 * I * RP + 32 * s + 16);
                        u32x4 aw = {a0.x, a0.y, a1.x, a1.y};
                        O[I] = __builtin_amdgcn_mfma_f32_32x32x16_bf16(*reinterpret_cast<bf16x8*>(&aw), bz, O[I], 0, 0, 0);
                    }
                    MB_SBAR();
                }
            }
            __syncthreads();
            pf_write_v(pf, lds);
            if (nxt) { pf_load_k(pf, Kg, t0 + 128); pf_load_q(pf, Qg, t0 + 128); }
        }
        __syncthreads();
        {
            RT_IDS(tz, lane, r32, hi, sr, sc)
            const int vb0 = (int)(uintptr_t)(lds + R0) + hd * 16384 + d0 * 512 + mb::v_rd_base(lane);
            const int vb1 = vb0 + (R1 - R0);
            const int kt0 = (int)(uintptr_t)(lds + R3) + mb::v_rd_base(lane);
            const int kt1 = kt0 + 16384;
            if constexpr (full) {
                cd_step<0, 0, true>(O, Z, lds, vb0, kt0, r32, hi); cd_step<0, 1, true>(O, Z, lds, vb0, kt0, r32, hi); cd_step<0, 2, true>(O, Z, lds, vb0, kt0, r32, hi); cd_step<0, 3, true>(O, Z, lds, vb0, kt0, r32, hi);
                cd_step<1, 0, true>(O, Z, lds, vb1, kt1, r32, hi); cd_step<1, 1, true>(O, Z, lds, vb1, kt1, r32, hi); cd_step<1, 2, true>(O, Z, lds, vb1, kt1, r32, hi); cd_step<1, 3, true>(O, Z, lds, vb1, kt1, r32, hi);
            } else {
                cd_step<0, 0, false>(O, Z, lds, vb0, kt0, r32, hi); cd_step<0, 1, false>(O, Z, lds, vb0, kt0, r32, hi); cd_step<0, 2, false>(O, Z, lds, vb0, kt0, r32, hi); cd_step<0, 3, false>(O, Z, lds, vb0, kt0, r32, hi);
                cd_step<1, 0, false>(O, Z, lds, vb1, kt1, r32, hi); cd_step<1, 1, false>(O, Z, lds, vb1, kt1, r32, hi); cd_step<1, 2, false>(O, Z, lds, vb1, kt1, r32, hi); cd_step<1, 3, false>(O, Z, lds, vb1, kt1, r32, hi);
            }
        }
        if constexpr (full) {
            __syncthreads();
            u32x4 gw[8];
            {
                RT_IDS(tz, lane, r32, hi, sr, sc)
                const bf16_t* gp = Gg + (long)(t0 + (tz >> 2)) * LD + 64 * (tz & 3);
#pragma unroll
                for (int i = 0; i < 8; ++i) gw[i] = *(const u32x4*)(gp + 8 * i);
            }
            {
                RT_IDS(tz, lane, r32, hi, sr, sc)
                LAS char* op = lds + R2 + (4 * hi) * OPITCH + (32 * wid + r32) * 2;
#pragma unroll
                for (int I = 0; I < 4; ++I)
#pragma unroll
                    for (int r = 0; r < 16; ++r)
                        *(LAS bf16_t*)(op + (32 * I + (r & 3) + 8 * (r >> 2)) * OPITCH) = (bf16_t)(cvt_pk_bf16(O[I][r], O[I][r]) & 0xffffu);
            }
            __syncthreads();
            {
                RT_IDS(tz, lane, r32, hi, sr, sc)
                const int row = tz >> 2, q = tz & 3;
                const LAS char* op = lds + R2 + row * OPITCH + q * 128;
                u32x4 ov[8]; float ss = 0.f;
#pragma unroll
                for (int i = 0; i < 8; ++i) { ov[i] = *(const LAS u32x4*)(op + 16 * i);
                    const float a0 = bf_lo(ov[i].x), a1 = bf_hi(ov[i].x), a2 = bf_lo(ov[i].y), a3 = bf_hi(ov[i].y), a4 = bf_lo(ov[i].z), a5 = bf_hi(ov[i].z), a6 = bf_lo(ov[i].w), a7 = bf_hi(ov[i].w);
                    ss += a0 * a0 + a1 * a1 + a2 * a2 + a3 * a3 + a4 * a4 + a5 * a5 + a6 * a6 + a7 * a7; }
                ss += __shfl_xor(ss, 1); ss += __shfl_xor(ss, 2);
                const float rs = rsqrtf(ss * (1.0f / 256.0f) + EPS);
                const long t = (long)(b * S + t0 + row);
                bf16_t* dp = oretb + t * D + h * 256 + 64 * q;
#pragma unroll
                for (int i = 0; i < 8; ++i) {
                    u32x4 w;
                    w.x = cvt_pk_bf16(bf_lo(ov[i].x) * rs * bf_lo(gw[i].x), bf_hi(ov[i].x) * rs * bf_hi(gw[i].x));
                    w.y = cvt_pk_bf16(bf_lo(ov[i].y) * rs * bf_lo(gw[i].y), bf_hi(ov[i].y) * rs * bf_hi(gw[i].y));
                    w.z = cvt_pk_bf16(bf_lo(ov[i].z) * rs * bf_lo(gw[i].z), bf_hi(ov[i].z) * rs * bf_hi(gw[i].z));
                    w.w = cvt_pk_bf16(bf_lo(ov[i].w) * rs * bf_lo(gw[i].w), bf_hi(ov[i].w) * rs * bf_hi(gw[i].w));
                    *(u32x4*)(dp + 8 * i) = w;
                }
            }
        }
    }
}
__device__ __forceinline__ void ret_item(const bf16_t* __restrict__ projb, bf16_t* __restrict__ oretb, int b, int h, int seg, LAS char* lds) {
    constexpr long LD = INW;
    const int wid = __builtin_amdgcn_readfirstlane(threadIdx.x >> 6);
    const float lg2 = log2f(1.0f - exp2f(-5.0f - (float)h));
    const float cd = exp2f(128.0f * lg2);
    const bf16_t* Qg = projb + (long)(b * S) * LD + C_RQ + h * 128;
    const bf16_t* Kg = projb + (long)(b * S) * LD + C_RK + h * 128;
    const bf16_t* Vg = projb + (long)(b * S) * LD + C_RV + h * 256;
    const bf16_t* Gg = projb + (long)(b * S) * LD + C_RG + h * 256;
    f32x16 Z[4] = {};
    Pf pf;
    pf_load_k(pf, Kg, 0);
    if (seg > 0) pf_load_v(pf, Vg, 0); else pf_load_q(pf, Qg, 0);
    for (int c = 0; c < 4 * seg; ++c) ret_chunk<false>(Z, pf, Qg, Kg, Vg, Gg, oretb, b, h, c, c + 1 < 4 * seg ? 1 : 2, lg2, cd, wid, lds);
    for (int c = 4 * seg; c < 4 * seg + 4; ++c) ret_chunk<true>(Z, pf, Qg, Kg, Vg, Gg, oretb, b, h, c, c + 1 < 4 * seg + 4 ? 2 : 0, lg2, cd, wid, lds);
    __syncthreads();
}
#undef RT_IDS
#undef RT_PK
}


__device__ __forceinline__ void p2_item(int q, const bf16_t* projb, const float* kpart, bf16_t* omobab, bf16_t* oretb, LAS char* lds) {
    int kind, lvl, bh;
    if (q < 64) { kind = 0; lvl = 7; bh = q; } else if (q < 128) { kind = 0; lvl = 6; bh = q - 64; } else if (q < 160) { kind = 1; lvl = 3; bh = q - 128; }
    else if (q < 224) { kind = 0; lvl = 5; bh = q - 160; } else if (q < 256) { kind = 1; lvl = 2; bh = q - 224; } else if (q < 320) { kind = 0; lvl = 4; bh = q - 256; }
    else if (q < 352) { kind = 1; lvl = 1; bh = q - 320; } else if (q < 416) { kind = 0; lvl = 3; bh = q - 352; } else if (q < 448) { kind = 1; lvl = 0; bh = q - 416; }
    else if (q < 512) { kind = 0; lvl = 2; bh = q - 448; } else if (q < 576) { kind = 0; lvl = 1; bh = q - 512; } else { kind = 0; lvl = 0; bh = q - 576; }
    if (kind == 0) mb::moba_item(projb, kpart, omobab, bh / MH, bh % MH, lvl, lds);
    else rt::ret_item(projb, oretb, bh / RH, bh % RH, lvl, lds);
}
constexpr int P2_ITEMS = 640;

__global__ void __launch_bounds__(512, 2) mk_fwd(MKArgs a) {
    extern __shared__ __attribute__((aligned(16))) unsigned char shm[];
    char* ws = a.ws;
    const int wg = blockIdx.x, nwg = gridDim.x;
    LAS int* tab = (LAS int*)(shm + LDS_TAB);
    LAS int* qslot = (LAS int*)(shm + LDS_TAB + 512);
    XcdBarrier bar = xcd_barrier_post((unsigned*)(ws + WS_CTL + CTL_BAR), (unsigned*)(ws + WS_CTL + CTL_BST) + 2 * wg);
    int* counts = (int*)(ws + WS_CTL);
    unsigned* qhead = (unsigned*)(ws + WS_CTL + CTL_QHEAD);
    p0_rmsnorm_bf16(a.x, a.g_mix, (bf16_t*)(ws + WB_HB), (unsigned char*)(ws + WB_HB8), wg, nwg);
    p0_rope(a.pos, (float*)(ws + WS_ROPE), wg, nwg);
    p0_transpose<false, false, true>(a.w_in, (bf16_t*)(ws + WB_WINT), D, INW, 1, (LAS unsigned*)shm, wg, nwg, (unsigned char*)(ws + WB_WINT8));
    p0_transpose(a.w_reto, (bf16_t*)(ws + WB_WRT), D, D, 1, (LAS unsigned*)shm, wg, nwg);
    p0_transpose(a.w_mobao, (bf16_t*)(ws + WB_WMT), D, D, 1, (LAS unsigned*)shm, wg, nwg);
    p0_transpose(a.w_out, (bf16_t*)(ws + WB_WOT), D, D, 1, (LAS unsigned*)shm, wg, nwg);
    xcd_barrier(bar);
    typedef BgConv<D, 2 * F> BgGu; typedef BgConv<F, D> BgDn;
    BgGu bg_gu; bg_gu.init(a.w_gu, (bf16_t*)(ws + WB_WGUT), ws + WB_SCR, NE, wg, nwg);
    BgOff bgoff;
    {
        P1PolicyT<false> p; p.hA = ws + WB_HB; p.WinT = ws + WB_WINT; p.projb = (bf16_t*)(ws + WB_PROJB); p.rope = (const float*)(ws + WS_ROPE); p.kpart = (float*)(ws + WB_KPART); p.G = nwg; p.c = wg;
        p.i0 = 0; p.icnt = 1 << 20; bg_gu.lanes(); g8::gemm_phase<P1PolicyT<false>, BgGu>((LAS unsigned char*)shm, p, bg_gu);
        P1PolicyT<true> p8; p8.hA = ws + WB_HB8; p8.WinT = ws + WB_WINT8; p8.projb = p.projb; p8.rope = p.rope; p8.kpart = p.kpart; p8.G = nwg; p8.c = wg;
        p8.i0 = 0; p8.icnt = 1 << 20; bg_gu.lanes(); g8::gemm_phase<P1PolicyT<true>, BgGu>((LAS unsigned char*)shm, p8, bg_gu);
    }
    xcd_barrier(bar);
    for (;;) {
        __syncthreads();
        int z = 0; asm volatile("" : "+v"(z));
        if (threadIdx.x == 0) qslot[z] = (int)__hip_atomic_fetch_add(qhead, 1u, __ATOMIC_RELAXED, __HIP_MEMORY_SCOPE_AGENT);
        __syncthreads();
        const int q = qslot[z];
        if (q >= P2_ITEMS) break;
        p2_item(q, (const bf16_t*)(ws + WB_PROJB), (const float*)(ws + WB_KPART), (bf16_t*)(ws + WB_OMOBAB), (bf16_t*)(ws + WB_ORETB), (LAS char*)shm);
    }
    xcd_barrier(bar);
    {
        P3Policy p; p.A0 = ws + WB_ORETB; p.A1 = ws + WB_OMOBAB; p.W0 = ws + WB_WRT; p.W1 = ws + WB_WMT; p.projb = (const bf16_t*)(ws + WB_PROJB); p.tmp = (float*)(ws + WS_YRET);
        p.merged = (bf16_t*)(ws + WB_MERGEDB); p.G = nwg; p.c = wg;
        bg_gu.lanes(); g8::gemm_phase<P3Policy, BgGu>((LAS unsigned char*)shm, p, bg_gu);
    }
    xcd_barrier(bar);
    {
        P4Policy p; p.A = ws + WB_MERGEDB; p.W = ws + WB_WOT; p.x = a.x; p.xmid = (float*)(ws + WS_XMID); p.G = nwg; p.c = wg;
        bg_gu.lanes(); g8::gemm_phase<P4Policy, BgGu>((LAS unsigned char*)shm, p, bg_gu);
    }
    xcd_barrier(bar);
    if (wg & 1) {
        p5_router((const float*)(ws + WS_XMID), a.g_ffn, a.r_w, a.r_b, (bf16_t*)(ws + WB_H2B), (int*)(ws + WS_TOPI), (int*)(ws + WS_SLOT), counts,
                  (int*)(ws + WB_LISTC), (float*)(ws + WB_ROWWC), (LAS float*)shm, wg, nwg);
        __syncthreads();
        p0_transpose<false, true>(a.w_gu, (bf16_t*)(ws + WB_WGUT), D, 2 * F, NE, (LAS unsigned*)shm, wg + nwg * (bg_gu.step >> 2), nwg);
    } else {
        p0_transpose<false, true>(a.w_gu, (bf16_t*)(ws + WB_WGUT), D, 2 * F, NE, (LAS unsigned*)shm, wg + nwg * (bg_gu.step >> 2), nwg);
        p5_router((const float*)(ws + WS_XMID), a.g_ffn, a.r_w, a.r_b, (bf16_t*)(ws + WB_H2B), (int*)(ws + WS_TOPI), (int*)(ws + WS_SLOT), counts,
                  (int*)(ws + WB_LISTC), (float*)(ws + WB_ROWWC), (LAS float*)shm, wg, nwg);
    }
    xcd_barrier(bar);
    build_tile_table(counts, tab);
    LAS int* udesc = (LAS int*)(shm + LDS_TAB + 1024);
    build_unit_desc(tab, wg, udesc);
    {
        P6Policy p; p.ud = udesc; p.h2b = ws + WB_H2B; p.WguT = ws + WB_WGUT; p.listc = (const int*)(ws + WB_LISTC); p.bgu = a.b_gu; p.act = (bf16_t*)(ws + WB_ACTB); p.tab = tab; p.G = nwg; p.c = wg;
        const int cls = (wg >> 3) & 3;
        if (cls > 0) { p.i0 = 0; p.icnt = 2 * cls; g8::gemm_phase<P6Policy, BgOff>((LAS unsigned char*)shm, p, bgoff); }
        p0_transpose<false, true>(a.w_dn, (bf16_t*)(ws + WB_WDNT), F, D, NE, (LAS unsigned*)shm, wg, nwg);
        p.i0 = 2 * cls; p.icnt = 1 << 20; g8::gemm_phase<P6Policy, BgOff>((LAS unsigned char*)shm, p, bgoff);
    }
    xcd_barrier(bar);
    {
        P7Policy p; p.ud = udesc; p.actb = ws + WB_ACTB; p.WdnT = ws + WB_WDNT; p.rowwc = (const float*)(ws + WB_ROWWC); p.bdn = a.b_dn; p.yrow = (bf16_t*)(ws + WB_YROWB); p.tab = tab; p.G = nwg; p.c = wg;
        g8::gemm_phase<P7Policy, BgOff>((LAS unsigned char*)shm, p, bgoff);
    }
    xcd_barrier(bar);
    p8_final((const float*)(ws + WS_XMID), (const bf16_t*)(ws + WB_YROWB), (const int*)(ws + WS_TOPI), (const int*)(ws + WS_SLOT), tab, a.g_fin, a.out, wg, nwg);
}

extern "C" void kernel_launch(void* const* d_in, const int* in_sizes, int n_in, void* d_out, int out_size, void* d_ws, size_t ws_size, hipStream_t stream) {
    static int grid = 0;
    if (grid == 0) {
        if (n_in != 15 || ws_size < WB_END2) { fprintf(stderr, "kernel_launch: bad arguments (n_in %d, ws %zu < %zu)\n", n_in, ws_size, (size_t)WB_END2); grid = -1; return; }
        int dev = 0, cus = 0, per_cu = 0;
        if (hipGetDevice(&dev) != hipSuccess || hipDeviceGetAttribute(&cus, hipDeviceAttributeMultiprocessorCount, dev) != hipSuccess) { grid = -1; return; }
        if (hipFuncSetAttribute((const void*)mk_fwd, hipFuncAttributeMaxDynamicSharedMemorySize, LDS_BYTES) != hipSuccess) { fprintf(stderr, "kernel_launch: hipFuncSetAttribute failed\n"); grid = -1; return; }
        if (hipOccupancyMaxActiveBlocksPerMultiprocessor(&per_cu, (const void*)mk_fwd, 512, LDS_BYTES) != hipSuccess || per_cu < 1) { fprintf(stderr, "kernel_launch: occupancy query says %d\n", per_cu); per_cu = 1; }
        grid = cus;
    }
    if (grid < 0) return;
    char* ws = (char*)d_ws;
    (void)hipMemsetAsync(ws + WS_CTL, 0, CTL_BYTES, stream);
    MKArgs ma{};
    ma.x = (const float*)d_in[0]; ma.pos = (const int*)d_in[1]; ma.g_mix = (const float*)d_in[2]; ma.w_in = (const float*)d_in[3];
    ma.w_reto = (const float*)d_in[4]; ma.w_mobao = (const float*)d_in[5]; ma.w_out = (const float*)d_in[6]; ma.g_ffn = (const float*)d_in[7];
    ma.r_w = (const float*)d_in[8]; ma.r_b = (const float*)d_in[9]; ma.w_gu = (const float*)d_in[10]; ma.b_gu = (const float*)d_in[11];
    ma.w_dn = (const float*)d_in[12]; ma.b_dn = (const float*)d_in[13]; ma.g_fin = (const float*)d_in[14]; ma.out = (float*)d_out; ma.ws = ws;
    hipLaunchKernelGGL(mk_fwd, dim3(grid), dim3(512), LDS_BYTES, stream, ma);
}
```

```cpp
#include <hip/hip_runtime.h>
#include <cstdio>
#include <cstdint>

constexpr int D = 2048, NB = 4, S = 2048, T = NB * S;
constexpr int RH = 8;
constexpr int MH = 16, MBLK = 256, NKB = S / MBLK;
constexpr int NE = 32, F = 2048;
constexpr int INW = 16384;
constexpr int C_RQ = 0, C_RK = 1024, C_RV = 2048, C_RG = 4096, C_MQ = 6144, C_MK = 8192, C_MV = 10240, C_GT = 12288;
constexpr int PMAX = T * 4 + NE * 256;
constexpr float EPS = 1e-5f;

#define LAS __attribute__((address_space(3)))
#define XB_TMO      128
#define XB_XCNT(j)  (256  + 64 * (j))
#define XB_XSUB(j)  (1280 + 64 * (j))
#define XB_XGEN(j)  (2304 + 64 * (j))
#define XB_TOP      3328
#define XB_TOPGEN   3392
#define XCD_BAR_WORDS 3456
#define XB_SPIN_CAP (1u << 18)

__device__ __forceinline__ unsigned xb_ld(unsigned* p)              { return __hip_atomic_load(p, __ATOMIC_RELAXED, __HIP_MEMORY_SCOPE_AGENT); }
__device__ __forceinline__ unsigned xb_add(unsigned* p, unsigned v) { return __hip_atomic_fetch_add(p, v, __ATOMIC_RELAXED, __HIP_MEMORY_SCOPE_AGENT); }
__device__ __forceinline__ unsigned xb_xcc_id() { return (unsigned)__builtin_amdgcn_s_getreg((3 << 11) | 20) & 0xFu; }
#define XB_SPIN(cond, bar) do { unsigned _sp = 0; while (cond) { __builtin_amdgcn_s_sleep(1); \
    if ((++_sp & 255u) == 0u) { if (xb_ld(&(bar)[XB_TMO])) break; if (_sp > XB_SPIN_CAP) { atomicAdd(&(bar)[XB_TMO], 1u); break; } } } } while (0)

struct XcdBarrier {
    unsigned* bar; unsigned x;
    unsigned* st;
};

__device__ __forceinline__ XcdBarrier xcd_barrier_post(unsigned* bar, unsigned* st) {
    XcdBarrier b; b.bar = bar; b.x = xb_xcc_id(); b.st = st;
    if (threadIdx.x == 0) (void)xb_add(&bar[XB_XCNT(b.x)], 1u);
    return b;
}
__device__ __forceinline__ void xcd_barrier_complete(unsigned* bar, unsigned x, unsigned& nloc, unsigned& nx) {
    const unsigned G = gridDim.x * gridDim.y * gridDim.z;
    unsigned sum, cnt, mine, sp = 0u;
    for (;;) {
        sum = 0u; cnt = 0u; mine = 0u;
#pragma unroll
        for (unsigned j = 0; j < 16; ++j) { const unsigned c = xb_ld(&bar[XB_XCNT(j)]); sum += c; cnt += (c > 0u) ? 1u : 0u; mine = (j == x) ? c : mine; }
        if (sum == G) break;
        __builtin_amdgcn_s_sleep(1);
        if ((++sp & 255u) == 0u) { if (xb_ld(&bar[XB_TMO])) break; if (sp > XB_SPIN_CAP) { atomicAdd(&bar[XB_TMO], 1u); break; } }
    }
    nloc = mine > 0u ? mine : 1u; nx = cnt > 0u ? cnt : 1u;
}

__device__ __forceinline__ void xcd_barrier(const XcdBarrier& b) {
    asm volatile("s_waitcnt vmcnt(0)" ::: "memory");
    __syncthreads();
    if (threadIdx.x == 0) {
        unsigned* bar = b.bar;
        __builtin_amdgcn_s_waitcnt(0);
        unsigned nloc = xb_ld(&b.st[0]), nx = xb_ld(&b.st[1]);
        if (nloc == 0u) { xcd_barrier_complete(bar, b.x, nloc, nx); __hip_atomic_store(&b.st[0], nloc, __ATOMIC_RELAXED, __HIP_MEMORY_SCOPE_AGENT); __hip_atomic_store(&b.st[1], nx, __ATOMIC_RELAXED, __HIP_MEMORY_SCOPE_AGENT); }
        const unsigned old = xb_add(&bar[XB_XSUB(b.x)], 1u);
        const unsigned gen = old / nloc;
        if (old + 1u == (gen + 1u) * nloc) {
            __builtin_amdgcn_fence(__ATOMIC_RELEASE, "agent");
            asm volatile("s_waitcnt vmcnt(0)" ::: "memory");
            const unsigned og = xb_add(&bar[XB_TOP], 1u);
            const unsigned tg = og / nx;
            if (og + 1u == (tg + 1u) * nx) xb_add(&bar[XB_TOPGEN], 1u);
            else XB_SPIN(xb_ld(&bar[XB_TOPGEN]) == tg, bar);
            __builtin_amdgcn_fence(__ATOMIC_ACQUIRE, "agent");
            xb_add(&bar[XB_XGEN(b.x)], 1u);
            asm volatile("s_waitcnt vmcnt(0)" ::: "memory");
        } else {
            XB_SPIN(xb_ld(&bar[XB_XGEN(b.x)]) == gen, bar);
            __builtin_amdgcn_fence(__ATOMIC_ACQUIRE, "agent");
            asm volatile("s_waitcnt vmcnt(0)" ::: "memory");
        }
    }
    __syncthreads();
}


constexpr size_t AL(size_t x) { return (x + 255) & ~(size_t)255; }
constexpr size_t WS_CTL   = 0;
constexpr int CNT_STRIDE = 64;
constexpr size_t CTL_QHEAD = 8192, CTL_BAR = 12288;
constexpr size_t CTL_BST = CTL_BAR + ((XCD_BAR_WORDS * 4 + 255) / 256) * 256;
constexpr size_t CTL_BYTES = CTL_BST + 1024 * 8;
constexpr size_t WS_ROPE  = AL(WS_CTL + CTL_BYTES);
constexpr size_t WS_YRET  = AL(WS_ROPE + (size_t)T * 64 * 2 * 4);
constexpr size_t WS_XMID  = AL(WS_YRET + (size_t)T * D * 4);
constexpr size_t WS_TOPI  = AL(WS_XMID + (size_t)T * D * 4);
constexpr size_t WS_SLOT  = AL(WS_TOPI + (size_t)T * 4 * 4);
constexpr size_t WB_HB    = AL(WS_SLOT + (size_t)T * 4 * 4);
constexpr size_t WB_WINT  = AL(WB_HB + (size_t)T * D * 2);
constexpr size_t WB_WRT   = AL(WB_WINT + (size_t)INW * D * 2);
constexpr size_t WB_WMT   = AL(WB_WRT + (size_t)D * D * 2);
constexpr size_t WB_WOT   = AL(WB_WMT + (size_t)D * D * 2);
constexpr size_t WB_WGUT  = AL(WB_WOT + (size_t)D * D * 2);
constexpr size_t WB_WDNT  = AL(WB_WGUT + (size_t)NE * 2 * F * D * 2);
constexpr size_t WB_PROJB = AL(WB_WDNT + (size_t)NE * D * F * 2);
constexpr size_t WB_KPART = AL(WB_PROJB + (size_t)T * INW * 2);
constexpr size_t WB_ORETB = AL(WB_KPART + (size_t)32 * 2 * 2048 * 4);
constexpr size_t WB_OMOBAB= AL(WB_ORETB + (size_t)T * D * 2);
constexpr size_t WB_MERGEDB=AL(WB_OMOBAB + (size_t)T * D * 2);
constexpr size_t WB_H2B   = AL(WB_MERGEDB + (size_t)T * D * 2);
constexpr size_t WB_LISTC = AL(WB_H2B + (size_t)T * D * 2);
constexpr size_t WB_ROWWC = AL(WB_LISTC + (size_t)NE * T * 4);
constexpr size_t WB_ACTB  = AL(WB_ROWWC + (size_t)NE * T * 4);
constexpr size_t WB_YROWB = AL(WB_ACTB + (size_t)PMAX * F * 2);
constexpr size_t WB_SCR   = AL(WB_YROWB + (size_t)PMAX * D * 2);
constexpr size_t WB_HB8   = AL(WB_SCR + (size_t)1024 * 512 * 16);
constexpr size_t WB_WINT8 = AL(WB_HB8 + (size_t)T * D);
constexpr size_t WB_END2  = AL(WB_WINT8 + (size_t)INW * D);
constexpr int LDS_BYTES = 160 * 1024;
constexpr int LDS_MINI = 128 * 1024;
constexpr int LDS_TAB = 144 * 1024;

__device__ __forceinline__ int opaque_tid() { int t = threadIdx.x; asm volatile("" : "+v"(t)); return t; }
__device__ __forceinline__ float wave_sum(float v) {
#pragma unroll
    for (int o = 32; o >= 1; o >>= 1) v += __shfl_xor(v, o);
    return v;
}
typedef unsigned short bf16_t;
typedef short bf16x8 __attribute__((ext_vector_type(8)));
typedef float f32x4 __attribute__((ext_vector_type(4)));
typedef unsigned u32x4 __attribute__((ext_vector_type(4)));
typedef unsigned u32x2 __attribute__((ext_vector_type(2)));

__device__ __forceinline__ unsigned cvt_pk_bf16(float lo, float hi) { unsigned r; asm volatile("v_cvt_pk_bf16_f32 %0, %1, %2" : "=v"(r) : "v"(lo), "v"(hi)); return r; }
constexpr float WSCALE = 64.0f, WSCALE_INV = 1.0f / 64.0f;
constexpr float YSCALE = 16.0f, YSCALE_INV = 1.0f / 16.0f;
__device__ __forceinline__ unsigned pk4_fp8(float a, float b, float c, float d) {
    unsigned w = 0u;
    w = (unsigned)__builtin_amdgcn_cvt_pk_fp8_f32(a, b, (int)w, false);
    w = (unsigned)__builtin_amdgcn_cvt_pk_fp8_f32(c, d, (int)w, true);
    return w;
}
__device__ __forceinline__ float bf_lo(unsigned w) { return __uint_as_float(w << 16); }
__device__ __forceinline__ float bf_hi(unsigned w) { return __uint_as_float(w & 0xffff0000u); }
__device__ __forceinline__ float fast_sigmoid(float x) { return __builtin_amdgcn_rcpf(1.0f + __expf(-x)); }


struct BgOff { static constexpr bool ON = false; };
template <int KK, int NN>
struct BgConv {
    static constexpr bool ON = true;
    const float* src; bf16_t* dst; char* scratch;
    int c, G, step, nsteps;
    int cur_step, cur_valid, par;
    unsigned dsrc[2], drd, dsto, dscr;
    __device__ __forceinline__ void init(const float* s_, bf16_t* d_, char* scr, int nmat, int c_, int G_) {
        src = s_; dst = d_; scratch = scr + (size_t)c_ * 512 * 16; c = c_; G = G_; step = 0; cur_step = 0; cur_valid = 0; par = 0;
        const int total = nmat * (KK / 64) * (NN / 256); nsteps = 4 * ((total - c_ + G_ - 1) / G_);
    }
    __device__ __forceinline__ void lanes() {
        const int tid = opaque_tid();
        dscr = (unsigned)tid * 16u;
        const int wid = tid >> 6, lane = tid & 63;
#pragma unroll
        for (int q = 0; q < 2; ++q) { const int r = 4 * (wid * 2 + q) + (lane >> 4), pos = lane & 15, cidx = (pos - (r >> 3)) & 15; dsrc[q] = (unsigned)(r * NN * 4 + cidx * 16); }
        const int n = tid >> 3, k8 = tid & 7;
        drd = (unsigned)((8 * k8) * 256 + (((n >> 2) + k8) & 15) * 16 + (n & 3) * 4);
        dsto = (unsigned)(n * KK + 8 * k8);
    }
    __device__ __forceinline__ void bases(int s, const char*& sb, char*& db) const {
        const int jt = s >> 2, q = s & 3, tile = c + G * jt;
        constexpr int ntk = KK / 64, ntn = NN / 256;
        const int mat = tile / (ntk * ntn), rem = tile % (ntk * ntn), kt = rem / ntn, ntile = rem % ntn;
        sb = (const char*)src + ((size_t)(mat * KK + kt * 64) * NN + ntile * 256 + 64 * q) * 4;
        db = (char*)dst + ((size_t)(mat * NN + ntile * 256 + 64 * q) * KK + kt * 64);
    }
    __device__ __forceinline__ void issue(LAS unsigned char* lds, int wid) {
        const int s = step < nsteps ? step : nsteps - 1;
        const char* sb; char* db; bases(s, sb, db); (void)db;
#pragma unroll
        for (int q = 0; q < 2; ++q)
            __builtin_amdgcn_global_load_lds((const unsigned*)(sb + dsrc[q]), (LAS unsigned*)(lds + LDS_MINI + par * 16384 + (wid * 2 + q) * 1024), 16, 0, 2);
        par ^= 1; cur_step = s; cur_valid = step < nsteps ? 1 : 0; if (step < nsteps) ++step;
    }
    __device__ __forceinline__ void consume(LAS unsigned char* lds) {
        const LAS unsigned char* rp = lds + LDS_MINI + (par ^ 1) * 16384 + drd;
        float v[8];
#pragma unroll
        for (int j = 0; j < 8; ++j) v[j] = *(const LAS float*)(rp + j * 256);
        u32x2 w; w.x = pk4_fp8(v[0] * WSCALE, v[1] * WSCALE, v[2] * WSCALE, v[3] * WSCALE); w.y = pk4_fp8(v[4] * WSCALE, v[5] * WSCALE, v[6] * WSCALE, v[7] * WSCALE);
        const char* sb; char* db; bases(cur_step, sb, db); (void)sb;
        char* p = cur_valid ? db + dsto : scratch + dscr;
        __builtin_nontemporal_store(w, (u32x2*)p);
        cur_valid = 0;
    }
};

namespace g8 {
constexpr int BM = 256, BK = 64, HALF = 128, HTB = HALF * BK * 2, STAGE_BYTES = 8 * HTB, NXCD = 8, WGM = 8;
__host__ __device__ __forceinline__ int lds_byte(int r, int c) { const int st = (r >> 4) * 2 + (c >> 5), rr = r & 15, cc = c & 31, ob = rr * 64 + cc * 2; return st * 1024 + (ob ^ (((ob >> 9) & 1) << 5)); }
__host__ __device__ __forceinline__ void stage_rc(int b, int& R, int& C) { const int st = b / 1024, sb = b % 1024, swz = sb ^ (((sb >> 9) & 1) << 5); R = (st >> 1) * 16 + swz / 64; C = (st & 1) * 32 + (swz % 64) / 2; }
__host__ __device__ __forceinline__ int perm32(int rho) { const int n = rho >> 4, i = rho & 15; return 8 * (i >> 2) + 4 * n + (i & 3); }

struct Unit { const char* A; const char* B; int pm, pn, e, aux; };

template <class P, class BG>
__device__ __forceinline__ void gemm_phase(LAS unsigned char* lds, const P& p, BG& bg) {
    const int tid = opaque_tid(), wid = __builtin_amdgcn_readfirstlane(tid >> 6), lane = tid & 63, wr = wid >> 2, wc = wid & 3, fr = lane & 15, fq = lane >> 4;
    const int K = p.K(), nt = K / BK;
    Unit cur, nxt; int ui = 0;
    if (!p.next(0, cur)) return;
    int sR[2], sC[2];
#pragma unroll
    for (int i = 0; i < 2; ++i) stage_rc(tid * 16 + i * 8192, sR[i], sC[i]);
    unsigned voffB[2][2], voffA[2][2], voffAn[2][2];
#pragma unroll
    for (int h = 0; h < 2; ++h)
#pragma unroll
        for (int i = 0; i < 2; ++i) { voffB[h][i] = p.boff(h, sR[i]) + (unsigned)sC[i] * 2u; voffA[h][i] = p.aoff(cur, h, sR[i]) + (unsigned)sC[i] * 2u; voffAn[h][i] = voffA[h][i]; }
    const size_t kstep = (size_t)(BK * 2);
    const unsigned ldsw = (unsigned)wid * 1024u;
    const int aoff = lds_byte(wr * 64 + fr, fq * 8), boff = lds_byte(wc * 32 + fr, fq * 8);
#define G8_SA(b, h) (((b) * 2 + (h)) * HTB)
#define G8_SB(b, h) ((4 + (b) * 2 + (h)) * HTB)
#define G8_STAGE(bufoff, gbase, voff) do { _Pragma("unroll") for (int _i = 0; _i < 2; ++_i) \
        __builtin_amdgcn_global_load_lds((const unsigned*)((const char*)(gbase) + (voff)[_i]), (LAS unsigned*)(lds + (bufoff) + ldsw + _i * 8192), 16, 0, 0); } while (0)
    typedef int i32x4_t __attribute__((ext_vector_type(4))); typedef int i32x8_t __attribute__((ext_vector_type(8)));
#define G8_CAT(x0, x1) __builtin_shufflevector(x0, x1, 0, 1, 2, 3, 4, 5, 6, 7)
#define G8_LO(x) __builtin_bit_cast(bf16x8, __builtin_shufflevector(x, x, 0, 1, 2, 3))
#define G8_HI(x) __builtin_bit_cast(bf16x8, __builtin_shufflevector(x, x, 4, 5, 6, 7))
#define G8_LDA(dst, b, h) do { _Pragma("unroll") for (int m = 0; m < 4; ++m) dst[m] = G8_CAT(*(const LAS i32x4_t*)(lds + G8_SA(b, h) + aoff + m * 2048), *(const LAS i32x4_t*)(lds + G8_SA(b, h) + aoff + m * 2048 + 1024)); } while (0)
#define G8_LDB(dst, b, h) do { _Pragma("unroll") for (int n = 0; n < 2; ++n) dst[n] = G8_CAT(*(const LAS i32x4_t*)(lds + G8_SB(b, h) + boff + n * 2048), *(const LAS i32x4_t*)(lds + G8_SB(b, h) + boff + n * 2048 + 1024)); } while (0)
#define G8_MMA(ai, bj, At, Bt) do { __builtin_amdgcn_s_setprio(1); \
        if constexpr (P::F8) { _Pragma("unroll") for (int m = 0; m < 4; ++m) _Pragma("unroll") for (int n = 0; n < 2; ++n) \
            asm volatile("v_mfma_scale_f32_16x16x128_f8f6f4 %0, %1, %2, %0, %3, %3 op_sel_hi:[0,0,0]" : "+v"(acc[ai][bj][m][n]) : "v"(Bt[n]), "v"(At[m]), "v"(one_scale)); } \
        else { _Pragma("unroll") for (int m = 0; m < 4; ++m) _Pragma("unroll") for (int n = 0; n < 2; ++n) { \
            acc[ai][bj][m][n] = __builtin_amdgcn_mfma_f32_16x16x32_bf16(G8_LO(Bt[n]), G8_LO(At[m]), acc[ai][bj][m][n], 0, 0, 0); \
            acc[ai][bj][m][n] = __builtin_amdgcn_mfma_f32_16x16x32_bf16(G8_HI(Bt[n]), G8_HI(At[m]), acc[ai][bj][m][n], 0, 0, 0); } } \
        __builtin_amdgcn_s_setprio(0); } while (0)
#define G8_WAIT_V(n) asm volatile("s_waitcnt vmcnt(" #n ")" ::: "memory")
#define G8_WAIT_L(n) asm volatile("s_waitcnt lgkmcnt(" #n ")" ::: "memory")
#define G8_BAR __builtin_amdgcn_s_barrier()
#define G8_SCHED __builtin_amdgcn_sched_barrier(0)
    f32x4 acc[2][2][4][2];
#pragma unroll
    for (int a = 0; a < 2; ++a)
#pragma unroll
        for (int b = 0; b < 2; ++b)
#pragma unroll
            for (int m = 0; m < 4; ++m)
#pragma unroll
                for (int n = 0; n < 2; ++n) acc[a][b][m][n] = (f32x4){0.f, 0.f, 0.f, 0.f};
    i32x8_t At[4], B0[2], B1[2];
    const int one_scale = 0x7f7f7f7f;
    const char* cA = cur.A; const char* cB = cur.B;
    G8_STAGE(G8_SB(0, 0), cB, voffB[0]); G8_STAGE(G8_SB(0, 1), cB, voffB[1]); G8_STAGE(G8_SA(0, 0), cA, voffA[0]); G8_STAGE(G8_SA(0, 1), cA, voffA[1]);
    if (wr == 1) G8_BAR;
    G8_WAIT_V(2); G8_BAR;
    G8_STAGE(G8_SB(1, 0), cB + kstep, voffB[0]); G8_STAGE(G8_SA(1, 0), cA + kstep, voffA[0]); G8_STAGE(G8_SB(1, 1), cB + kstep, voffB[1]);
    if constexpr (BG::ON) {
        G8_STAGE(G8_SB(1, 1), cB + kstep, voffB[1]);
        __builtin_amdgcn_global_load_lds((const unsigned*)((const char*)(cA + kstep) + voffA[0][0]), (LAS unsigned*)(lds + G8_SA(1, 0) + ldsw), 16, 0, 0);
        G8_WAIT_V(9);
    } else { G8_WAIT_V(6); }
    G8_BAR;
    for (;;) {
        const bool has_next = p.next(ui + 1, nxt);
        const char* nA = has_next ? nxt.A : cA; const char* nB = has_next ? nxt.B : cB;
        for (int t = 0; t < nt; t += 2) {
            const bool last = (t == nt - 2);
            const char* a1 = cA + (size_t)(t + 1) * kstep;
            const char* a2 = last ? nA : cA + (size_t)(t + 2) * kstep; const char* b2 = last ? nB : cB + (size_t)(t + 2) * kstep;
            const char* a3 = a2 + kstep; const char* b3 = b2 + kstep;
            const bool usen = P::AVAR && last && has_next;
            if constexpr (P::AVAR) {
                if (usen) {
#pragma unroll
                    for (int h = 0; h < 2; ++h)
#pragma unroll
                        for (int i = 0; i < 2; ++i) voffAn[h][i] = p.aoff(nxt, h, sR[i]) + (unsigned)sC[i] * 2u;
                }
            }
#define G8_STAGE_A2(bufoff, gbase, h) do { _Pragma("unroll") for (int _i = 0; _i < 2; ++_i) \
        __builtin_amdgcn_global_load_lds((const unsigned*)((const char*)(gbase) + (usen ? voffAn[h][_i] : voffA[h][_i])), (LAS unsigned*)(lds + (bufoff) + ldsw + _i * 8192), 16, 0, 0); } while (0)
            G8_LDB(B0, 0, 0); G8_LDB(B1, 0, 1); G8_SCHED; G8_LDA(At, 0, 0); G8_STAGE(G8_SA(1, 1), a1, voffA[1]);
            if constexpr (BG::ON) { G8_WAIT_V(11); } else { G8_WAIT_V(8); }
            G8_WAIT_L(0); G8_BAR; G8_MMA(0, 0, At, B0); G8_MMA(0, 1, At, B1); G8_BAR; G8_SCHED;
            G8_LDA(At, 0, 1); G8_STAGE(G8_SB(0, 0), b2, voffB[0]); G8_STAGE(G8_SB(0, 1), b2, voffB[1]); G8_STAGE_A2(G8_SA(0, 0), a2, 0);
            if constexpr (BG::ON) { G8_WAIT_V(11); } else { G8_WAIT_V(8); }
            G8_WAIT_L(0); G8_BAR; G8_MMA(1, 0, At, B0); G8_MMA(1, 1, At, B1); G8_BAR; G8_SCHED;
            G8_LDB(B0, 1, 0); G8_LDB(B1, 1, 1); G8_SCHED; G8_LDA(At, 1, 0); G8_STAGE_A2(G8_SA(0, 1), a2, 1);
            G8_WAIT_V(8); G8_WAIT_L(0); G8_BAR; G8_MMA(0, 0, At, B0); G8_MMA(0, 1, At, B1); G8_BAR; G8_SCHED;
            G8_LDA(At, 1, 1); G8_STAGE(G8_SB(1, 0), b3, voffB[0]); G8_STAGE(G8_SB(1, 1), b3, voffB[1]); G8_STAGE_A2(G8_SA(1, 0), a3, 0);
            if constexpr (BG::ON) { bg.consume(lds); bg.issue(lds, wid); G8_WAIT_V(11); } else { G8_WAIT_V(8); }
            G8_WAIT_L(0); G8_BAR; G8_MMA(1, 0, At, B0); G8_MMA(1, 1, At, B1); G8_BAR; G8_SCHED;
        }
        if constexpr (P::F8) asm volatile("s_nop 7\n\ts_nop 7\n\ts_nop 7" ::: "memory");
        if (wr == 0) G8_BAR;
        { int tz = threadIdx.x; asm volatile("" : "+v"(tz));
          const int l2 = tz & 63; p.epi(acc, cur, wr, wc, l2 & 15, l2 >> 4); }
        if (!has_next) break;
#pragma unroll
        for (int a = 0; a < 2; ++a)
#pragma unroll
            for (int b = 0; b < 2; ++b)
#pragma unroll
                for (int m = 0; m < 4; ++m)
#pragma unroll
                    for (int n = 0; n < 2; ++n) acc[a][b][m][n] = (f32x4){0.f, 0.f, 0.f, 0.f};
        cur = nxt; cA = nA; cB = nB; ++ui;
        if (wr == 1) G8_BAR;
        if constexpr (P::AVAR) {
#pragma unroll
            for (int h = 0; h < 2; ++h)
#pragma unroll
                for (int i = 0; i < 2; ++i) voffA[h][i] = voffAn[h][i];
        }
    }
    G8_WAIT_V(0);
    G8_BAR;
    if constexpr (BG::ON) { bg.consume(lds); G8_WAIT_L(0); G8_BAR; }
#undef G8_STAGE_A2
#undef G8_SA
#undef G8_SB
#undef G8_STAGE
#undef G8_LDA
#undef G8_LDB
#undef G8_MMA
#undef G8_CAT
#undef G8_LO
#undef G8_HI
#undef G8_WAIT_V
#undef G8_WAIT_L
#undef G8_BAR
#undef G8_SCHED
}
__device__ __forceinline__ bool static_unit(int i, int G, int c, int nM, int nN, int& pm, int& pn) {
    const int nwg = nM * nN; const long L = (long)i * G + c; if (L >= nwg) return false;
    int wgid = (int)L; { const int q = nwg / NXCD, r = nwg % NXCD, xcd = wgid % NXCD, off = wgid / NXCD; wgid = (xcd < r ? xcd * (q + 1) : r * (q + 1) + (xcd - r) * q) + off; }
    const int nig = WGM * nN, gid = wgid / nig, fm = gid * WGM, gsz = (nM - fm) < WGM ? (nM - fm) : WGM;
    pm = fm + ((wgid % nig) % gsz); pn = (wgid % nig) / gsz; return true;
}
}

__device__ __forceinline__ void p0_rmsnorm_bf16(const float* __restrict__ x, const float* __restrict__ g, bf16_t* __restrict__ out, unsigned char* __restrict__ out8, int wg, int nwg) {
    const int tz = opaque_tid(), wid = tz >> 6, lane = tz & 63;
    for (int row = wg * 8 + wid; row < T; row += nwg * 8) {
        const float4* xr = (const float4*)(x + (size_t)row * D);
        float4 v[8]; float ss = 0.f;
#pragma unroll
        for (int i = 0; i < 8; ++i) { v[i] = xr[lane + 64 * i]; ss += v[i].x * v[i].x + v[i].y * v[i].y + v[i].z * v[i].z + v[i].w * v[i].w; }
        ss = wave_sum(ss);
        const float r = rsqrtf(ss * (1.0f / D) + EPS);
#pragma unroll
        for (int i = 0; i < 8; ++i) {
            const float4 gg = ((const float4*)g)[lane + 64 * i];
            u32x2 w; w.x = cvt_pk_bf16(v[i].x * r * gg.x, v[i].y * r * gg.y); w.y = cvt_pk_bf16(v[i].z * r * gg.z, v[i].w * r * gg.w);
            *(u32x2*)(out + (size_t)row * D + (lane + 64 * i) * 4) = w;
            *(unsigned*)(out8 + (size_t)row * D + (lane + 64 * i) * 4) = pk4_fp8(v[i].x * r * gg.x, v[i].y * r * gg.y, v[i].z * r * gg.z, v[i].w * r * gg.w);
        }
    }
}
__device__ __forceinline__ void p0_rope(const int* __restrict__ pos, float* __restrict__ cs, int wg, int nwg) {
    for (int idx = wg * 512 + opaque_tid(); idx < T * 64; idx += nwg * 512) {
        const int t = idx >> 6, i = idx & 63;
        const float inv = powf(10000.0f, -(float)i / 64.0f);
        const float ang = (float)pos[t] * inv;
        float sn, cn; sincosf(ang, &sn, &cn);
        ((unsigned*)cs)[idx] = cvt_pk_bf16(cn, sn);
    }
}
__host__ __device__ __forceinline__ bool p1_fp8_unit(int pn) { return pn >= 48; }
struct TrRegs { f32x4 a[4], b[4]; };
__device__ __forceinline__ void tr_load(TrRegs& r, const float* __restrict__ src, int K, int N, int ntk, int ntn, int tile, int n4, int kp) {
    const int mat = tile / (ntk * ntn), rem = tile % (ntk * ntn), kt = rem / ntn, ntile = rem % ntn;
    const float* sp = src + ((size_t)mat * K + kt * 64 + 2 * kp) * N + ntile * 256 + 4 * n4;
#pragma unroll
    for (int s = 0; s < 4; ++s) { r.a[s] = __builtin_nontemporal_load((const f32x4*)(sp + 64 * s)); r.b[s] = __builtin_nontemporal_load((const f32x4*)(sp + N + 64 * s)); }
}
__device__ __forceinline__ void tr_lds_write(const TrRegs& r, LAS unsigned* lt, int n4, int kp) {
#pragma unroll
    for (int s = 0; s < 4; ++s) {
        const int n = 64 * s + 4 * n4;
        lt[(n + 0) * 33 + kp] = cvt_pk_bf16(r.a[s][0], r.b[s][0]); lt[(n + 1) * 33 + kp] = cvt_pk_bf16(r.a[s][1], r.b[s][1]);
        lt[(n + 2) * 33 + kp] = cvt_pk_bf16(r.a[s][2], r.b[s][2]); lt[(n + 3) * 33 + kp] = cvt_pk_bf16(r.a[s][3], r.b[s][3]);
    }
}
__device__ __forceinline__ void tr_store(bf16_t* __restrict__ dst, int K, int N, int ntk, int ntn, int tile, const LAS unsigned* lt, int t) {
    const int mat = tile / (ntk * ntn), rem = tile % (ntk * ntn), kt = rem / ntn, ntile = rem % ntn;
    bf16_t* dp = dst + ((size_t)mat * N + ntile * 256) * K + kt * 64;
#pragma unroll
    for (int q = 0; q < 4; ++q) {
        const int chunk = t + 512 * q, n = chunk >> 3, k8 = chunk & 7;
        u32x4 w; w.x = lt[n * 33 + 4 * k8]; w.y = lt[n * 33 + 4 * k8 + 1]; w.z = lt[n * 33 + 4 * k8 + 2]; w.w = lt[n * 33 + 4 * k8 + 3];
        *(u32x4*)(dp + (size_t)n * K + k8 * 8) = w;
    }
}
__device__ __forceinline__ void tr_store8(unsigned char* __restrict__ dst, int K, int N, int ntk, int ntn, int tile, const LAS unsigned* lt, int t) {
    const int mat = tile / (ntk * ntn), rem = tile % (ntk * ntn), kt = rem / ntn, ntile = rem % ntn;
    unsigned char* dp = dst + ((size_t)mat * N + ntile * 256) * K + kt * 64;
#pragma unroll
    for (int q = 0; q < 2; ++q) {
        const int chunk = t + 512 * q, n = chunk >> 2, k16 = chunk & 3;
        unsigned v[8];
#pragma unroll
        for (int j = 0; j < 8; ++j) v[j] = lt[n * 33 + 8 * k16 + j];
        u32x4 w;
        w.x = pk4_fp8(bf_lo(v[0]) * WSCALE, bf_hi(v[0]) * WSCALE, bf_lo(v[1]) * WSCALE, bf_hi(v[1]) * WSCALE);
        w.y = pk4_fp8(bf_lo(v[2]) * WSCALE, bf_hi(v[2]) * WSCALE, bf_lo(v[3]) * WSCALE, bf_hi(v[3]) * WSCALE);
        w.z = pk4_fp8(bf_lo(v[4]) * WSCALE, bf_hi(v[4]) * WSCALE, bf_lo(v[5]) * WSCALE, bf_hi(v[5]) * WSCALE);
        w.w = pk4_fp8(bf_lo(v[6]) * WSCALE, bf_hi(v[6]) * WSCALE, bf_lo(v[7]) * WSCALE, bf_hi(v[7]) * WSCALE);
        *(u32x4*)(dp + (size_t)n * K + k16 * 16) = w;
    }
}
template <bool NOSTORE = false, bool F8 = false, bool MIX = false>
__device__ __forceinline__ void p0_transpose(const float* __restrict__ src, bf16_t* __restrict__ dst, int K, int N, int nmat, LAS unsigned* lt, int wg, int nwg, unsigned char* dst8 = nullptr) {
    const int t = opaque_tid(), n4 = t & 15, kp = t >> 4;
    const int ntk = K / 64, ntn = N / 256, total = nmat * ntk * ntn;
    TrRegs r0, r1;
    const int last = total - 1;
    int tile = wg;
    if (tile >= total) return;
    tr_load(r0, src, K, N, ntk, ntn, min(tile, last), n4, kp);
    tr_load(r1, src, K, N, ntk, ntn, min(tile + nwg, last), n4, kp);
    for (; tile < total; tile += 2 * nwg) {
        __syncthreads();
        tr_lds_write(r0, lt, n4, kp);
        __syncthreads();
        tr_load(r0, src, K, N, ntk, ntn, min(tile + 2 * nwg, last), n4, kp);
        if (!NOSTORE) { if constexpr (MIX) { if (p1_fp8_unit(tile % ntn)) tr_store8(dst8, K, N, ntk, ntn, tile, lt, t); else tr_store(dst, K, N, ntk, ntn, tile, lt, t); }
                        else if constexpr (F8) tr_store8((unsigned char*)dst, K, N, ntk, ntn, tile, lt, t); else tr_store(dst, K, N, ntk, ntn, tile, lt, t); }
        __syncthreads();
        tr_lds_write(r1, lt, n4, kp);
        __syncthreads();
        tr_load(r1, src, K, N, ntk, ntn, min(tile + 3 * nwg, last), n4, kp);
        if (!NOSTORE && tile + nwg < total) { if constexpr (MIX) { if (p1_fp8_unit((tile + nwg) % ntn)) tr_store8(dst8, K, N, ntk, ntn, tile + nwg, lt, t); else tr_store(dst, K, N, ntk, ntn, tile + nwg, lt, t); }
                        else if constexpr (F8) tr_store8((unsigned char*)dst, K, N, ntk, ntn, tile + nwg, lt, t); else tr_store(dst, K, N, ntk, ntn, tile + nwg, lt, t); }
    }
    __syncthreads();
}


template <bool F8_>
struct P1PolicyT {
    const char* hA; const char* WinT; bf16_t* projb; const float* rope; float* kpart; int G, c, i0, icnt;
    static constexpr bool AVAR = false; static constexpr bool F8 = F8_;
    static constexpr int ES = F8_ ? 1 : 2;
    __device__ __forceinline__ int K() const { return F8_ ? D / 2 : D; }
    __device__ __forceinline__ bool next(int i, g8::Unit& u) const {
        if (i >= icnt) return false;
        int pm, idx; if (!g8::static_unit(i0 + i, G, c, T / 256, F8_ ? 16 : 48, pm, idx)) return false;
        const int pn = F8_ ? idx + 48 : idx;
        u.pm = pm; u.pn = pn; u.e = 0; u.aux = 0; u.A = hA + (size_t)pm * 256 * D * ES; u.B = WinT + (size_t)pn * 256 * D * ES; return true;
    }
    __device__ __forceinline__ unsigned aoff(const g8::Unit&, int h, int R) const { return (unsigned)((h * 128 + R) * D * ES); }
    __device__ __forceinline__ unsigned boff(int h, int R) const { return (unsigned)((128 * (R >> 6) + 64 * h + 32 * ((R >> 5) & 1) + g8::perm32(R & 31)) * D * ES); }
    template <bool SCALE, bool KSUM>
    __device__ __forceinline__ void epi_rot(const f32x4 (&acc)[2][2][4][2], const g8::Unit& u, int wr, int fr, int colb, int dd0, int ksum_col) const {
        const unsigned* rp = (const unsigned*)rope;
        const float sc = SCALE ? 0.08838834764831845f : 1.0f;
        constexpr int NB2 = KSUM ? 1 : 2;
        float cs0[2][2][4];
#pragma unroll
        for (int b = 0; b < 2; ++b)
#pragma unroll
            for (int n = 0; n < 2; ++n)
#pragma unroll
                for (int j = 0; j < 4; ++j) cs0[b][n][j] = 0.f;
#pragma unroll
        for (int g0 = 0; g0 < 8; g0 += NB2) {
            u32x4 ra[NB2], rb[NB2];
#pragma unroll
            for (int mm = 0; mm < NB2; ++mm) {
                const int ai = (g0 + mm) >> 2, m = (g0 + mm) & 3;
                const int t = 256 * u.pm + 128 * ai + 64 * wr + 16 * m + fr;
                ra[mm] = *(const u32x4*)(rp + (size_t)t * 64 + dd0); rb[mm] = *(const u32x4*)(rp + (size_t)t * 64 + dd0 + 4);
            }
#pragma unroll
            for (int mm = 0; mm < NB2; ++mm) {
                const int ai = (g0 + mm) >> 2, m = (g0 + mm) & 3;
                const int t = 256 * u.pm + 128 * ai + 64 * wr + 16 * m + fr;
                float o[2][2][4];
#pragma unroll
                for (int n = 0; n < 2; ++n) {
                    const u32x4 w = n ? rb[mm] : ra[mm];
                    const f32x4 x1 = acc[ai][0][m][n], x2 = acc[ai][1][m][n];
#pragma unroll
                    for (int j = 0; j < 4; ++j) {
                        const float c = bf_lo(w[j]) * sc, sn = bf_hi(w[j]) * sc;
                        o[0][n][j] = x1[j] * c - x2[j] * sn; o[1][n][j] = x2[j] * c + x1[j] * sn;
                        if (KSUM) { cs0[0][n][j] += o[0][n][j]; cs0[1][n][j] += o[1][n][j]; }
                    }
                }
                bf16_t* rowp = projb + (size_t)t * INW + colb;
#pragma unroll
                for (int b = 0; b < 2; ++b) {
                    u32x4 w; w.x = cvt_pk_bf16(o[b][0][0], o[b][0][1]); w.y = cvt_pk_bf16(o[b][0][2], o[b][0][3]); w.z = cvt_pk_bf16(o[b][1][0], o[b][1][1]); w.w = cvt_pk_bf16(o[b][1][2], o[b][1][3]);
                    *(u32x4*)(rowp + 64 * b) = w;
                }
            }
            __builtin_amdgcn_sched_barrier(0);
        }
        if (KSUM) {
#pragma unroll
            for (int b = 0; b < 2; ++b)
#pragma unroll
                for (int n = 0; n < 2; ++n)
#pragma unroll
                    for (int j = 0; j < 4; ++j) {
                        float v = cs0[b][n][j];
                        v += __shfl_xor(v, 1); v += __shfl_xor(v, 2); v += __shfl_xor(v, 4); v += __shfl_xor(v, 8);
                        cs0[b][n][j] = v;
                    }
            if (fr == 0) {
                float* kp = kpart + ((size_t)(u.pm * 2 + wr)) * 2048 + ksum_col;
#pragma unroll
                for (int b = 0; b < 2; ++b) {
                    *(f32x4*)(kp + 64 * b) = (f32x4){cs0[b][0][0], cs0[b][0][1], cs0[b][0][2], cs0[b][0][3]};
                    *(f32x4*)(kp + 64 * b + 4) = (f32x4){cs0[b][1][0], cs0[b][1][1], cs0[b][1][2], cs0[b][1][3]};
                }
            }
        }
    }
    template <int ACT>
    __device__ __forceinline__ void epi_act(const f32x4 (&acc)[2][2][4][2], const g8::Unit& u, int wr, int fr, int colb) const {
#pragma unroll
        for (int ai = 0; ai < 2; ++ai)
#pragma unroll
            for (int m = 0; m < 4; ++m) {
                const int t = 256 * u.pm + 128 * ai + 64 * wr + 16 * m + fr;
                bf16_t* rowp = projb + (size_t)t * INW + colb;
#pragma unroll
                for (int b = 0; b < 2; ++b) {
                    float o[8];
#pragma unroll
                    for (int n = 0; n < 2; ++n)
#pragma unroll
                        for (int j = 0; j < 4; ++j) { float x = F8_ ? acc[ai][b][m][n][j] * WSCALE_INV : acc[ai][b][m][n][j];
                            if (ACT != 0) asm volatile("" : "+v"(x));
                            o[4 * n + j] = ACT == 0 ? x : ACT == 1 ? x * fast_sigmoid(x) : fast_sigmoid(x); }
                    u32x4 w; w.x = cvt_pk_bf16(o[0], o[1]); w.y = cvt_pk_bf16(o[2], o[3]); w.z = cvt_pk_bf16(o[4], o[5]); w.w = cvt_pk_bf16(o[6], o[7]);
                    *(u32x4*)(rowp + 64 * b) = w;
                }
                if (ACT != 0) __builtin_amdgcn_sched_barrier(0);
            }
    }
    __device__ __forceinline__ void epi(const f32x4 (&acc)[2][2][4][2], const g8::Unit& u, int wr, int wc, int fr, int fq) const {
        const int pn = u.pn, head = wc >> 1, dd0 = 32 * (wc & 1) + 8 * fq;
        const int colb = 256 * pn + 128 * head + dd0;
        if (pn >= 4 && pn < 8) epi_rot<true, false>(acc, u, wr, fr, colb, dd0, 0);
        else if (pn < 4 || (pn >= 24 && pn < 32)) epi_rot<false, false>(acc, u, wr, fr, colb, dd0, 0);
        else if (pn >= 32 && pn < 40) epi_rot<false, true>(acc, u, wr, fr, colb, dd0, 256 * (pn - 32) + 128 * head + dd0);
        else if (pn < 16 || (pn >= 40 && pn < 48)) epi_act<0>(acc, u, wr, fr, colb);
        else if (pn < 24) epi_act<1>(acc, u, wr, fr, colb);
        else epi_act<2>(acc, u, wr, fr, colb);
    }
};

struct MKArgs {
    const float* x; const int* pos; const float* g_mix; const float* w_in; const float* w_reto; const float* w_mobao; const float* w_out;
    const float* g_ffn; const float* r_w; const float* r_b; const float* w_gu; const float* b_gu; const float* w_dn; const float* b_dn; const float* g_fin;
    float* out; char* ws;
};
struct P3Policy {
    const char* A0; const char* A1; const char* W0; const char* W1; const bf16_t* projb; float* tmp; bf16_t* merged; int G, c;
    static constexpr bool AVAR = false; static constexpr bool F8 = false;
    __device__ __forceinline__ int K() const { return D; }
    __device__ __forceinline__ bool next(int i, g8::Unit& u) const {
        int pm, pn; if (!g8::static_unit(i >> 1, G, c, T / 256, D / 256, pm, pn)) return false;
        const int sub = i & 1;
        u.pm = pm; u.pn = pn; u.e = 0; u.aux = sub; u.A = (sub ? A1 : A0) + (size_t)pm * 256 * D * 2; u.B = (sub ? W1 : W0) + (size_t)pn * 256 * D * 2; return true;
    }
    __device__ __forceinline__ unsigned aoff(const g8::Unit&, int h, int R) const { return (unsigned)((h * 128 + R) * D * 2); }
    __device__ __forceinline__ unsigned boff(int h, int R) const { return (unsigned)((128 * h + 32 * (R >> 5) + g8::perm32(R & 31)) * D * 2); }
    __device__ __forceinline__ void epi(const f32x4 (&acc)[2][2][4][2], const g8::Unit& u, int wr, int wc, int fr, int fq) const {
        const int sub = u.aux;
        bf16_t* tmpb = (bf16_t*)tmp;
        const int c00 = 256 * u.pn + 32 * wc + 8 * fq;
#pragma unroll
        for (int aim = 0; aim < 4; ++aim) {
            const int ai = aim >> 1, m0 = (aim & 1) * 2;
            u32x4 gw[2][2], tw[2][2];
#pragma unroll
            for (int mm = 0; mm < 2; ++mm)
#pragma unroll
                for (int bj = 0; bj < 2; ++bj) {
                    const size_t t = (size_t)(256 * u.pm + 128 * ai + 64 * wr + 16 * (m0 + mm) + fr);
                    gw[mm][bj] = *(const u32x4*)(projb + t * INW + C_GT + (sub ? D : 0) + c00 + 128 * bj);
                    if (sub) tw[mm][bj] = *(const u32x4*)(tmpb + t * D + c00 + 128 * bj);
                }
#pragma unroll
            for (int mm = 0; mm < 2; ++mm)
#pragma unroll
                for (int bj = 0; bj < 2; ++bj) {
                    const int m = m0 + mm;
                    const size_t t = (size_t)(256 * u.pm + 128 * ai + 64 * wr + 16 * m + fr);
                    const u32x4 g4 = gw[mm][bj];
                    float v[8];
#pragma unroll
                    for (int q = 0; q < 4; ++q) {
                        v[2 * q] = acc[ai][bj][m][q >> 1][(2 * q) & 3] * bf_lo(g4[q]);
                        v[2 * q + 1] = acc[ai][bj][m][q >> 1][(2 * q + 1) & 3] * bf_hi(g4[q]);
                    }
                    if (sub) {
                        const u32x4 p4 = tw[mm][bj];
#pragma unroll
                        for (int q = 0; q < 4; ++q) { v[2 * q] += bf_lo(p4[q]); v[2 * q + 1] += bf_hi(p4[q]); }
                    }
                    u32x4 w; w.x = cvt_pk_bf16(v[0], v[1]); w.y = cvt_pk_bf16(v[2], v[3]); w.z = cvt_pk_bf16(v[4], v[5]); w.w = cvt_pk_bf16(v[6], v[7]);
                    *(u32x4*)((sub ? merged : tmpb) + t * D + c00 + 128 * bj) = w;
                }
            __builtin_amdgcn_sched_barrier(0);
        }
    }
};
struct P4Policy {
    const char* A; const char* W; const float* x; float* xmid; int G, c;
    static constexpr bool AVAR = false; static constexpr bool F8 = false;
    __device__ __forceinline__ int K() const { return D; }
    __device__ __forceinline__ bool next(int i, g8::Unit& u) const {
        int pm, pn; if (!g8::static_unit(i, G, c, T / 256, D / 256, pm, pn)) return false;
        u.pm = pm; u.pn = pn; u.e = 0; u.aux = 0; u.A = A + (size_t)pm * 256 * D * 2; u.B = W + (size_t)pn * 256 * D * 2; return true;
    }
    __device__ __forceinline__ unsigned aoff(const g8::Unit&, int h, int R) const { return (unsigned)((h * 128 + R) * D * 2); }
    __device__ __forceinline__ unsigned boff(int h, int R) const { return (unsigned)((128 * h + R) * D * 2); }
    __device__ __forceinline__ void epi(const f32x4 (&acc)[2][2][4][2], const g8::Unit& u, int wr, int wc, int fr, int fq) const {
#pragma unroll
        for (int aim = 0; aim < 4; ++aim) {
            const int ai = aim >> 1, m0 = (aim & 1) * 2;
            f32x4 xv[2][2][2];
#pragma unroll
            for (int mm = 0; mm < 2; ++mm)
#pragma unroll
                for (int bj = 0; bj < 2; ++bj)
#pragma unroll
                    for (int n = 0; n < 2; ++n) {
                        const size_t o = (size_t)(256 * u.pm + 128 * ai + 64 * wr + 16 * (m0 + mm) + fr) * D + 256 * u.pn + 128 * bj + 32 * wc + 16 * n + 4 * fq;
                        xv[mm][bj][n] = *(const f32x4*)(x + o);
                    }
#pragma unroll
            for (int mm = 0; mm < 2; ++mm)
#pragma unroll
                for (int bj = 0; bj < 2; ++bj)
#pragma unroll
                    for (int n = 0; n < 2; ++n) {
                        const size_t o = (size_t)(256 * u.pm + 128 * ai + 64 * wr + 16 * (m0 + mm) + fr) * D + 256 * u.pn + 128 * bj + 32 * wc + 16 * n + 4 * fq;
                        *(f32x4*)(xmid + o) = xv[mm][bj][n] + acc[ai][bj][m0 + mm][n];
                    }
            __builtin_amdgcn_sched_barrier(0);
        }
    }
};
__device__ __forceinline__ void p5_router(const float* __restrict__ xmid, const float* __restrict__ g, const float* __restrict__ rw, const float* __restrict__ rb,
                                          bf16_t* __restrict__ h2b, int* __restrict__ topi, int* __restrict__ slot, int* __restrict__ counts,
                                          int* __restrict__ listc, float* __restrict__ rowwc, LAS float* lds  , int wg, int nwg) {
    typedef float f32x16 __attribute__((ext_vector_type(16)));
    const int tz = opaque_tid(), wid = __builtin_amdgcn_readfirstlane(tz >> 6), lane = tz & 63, i32 = lane & 31, kk = lane >> 5;
    LAS float* part = lds; LAS float* rs = lds + 8 * 32 * 32;
    LAS int* lcnt = (LAS int*)(rs + 32); LAS int* lbase = lcnt + 32; LAS int* asg_e = lbase + 32; LAS int* asg_r = asg_e + 128; LAS float* asg_w = (LAS float*)(asg_r + 128);
    if (tz < NE) lcnt[tz] = 0;
    __syncthreads();
    for (int tile = wg; tile < T / 32; tile += nwg) {
        const int t0 = tile * 32;
        f32x16 acc = {};
        const float* arow = xmid + (size_t)(t0 + i32) * D + 256 * wid + 4 * kk;
        const float* brow = rw + (size_t)(256 * wid + 4 * kk) * NE + i32;
        const float* gp = g + 256 * wid + 4 * kk;
#pragma unroll 4
        for (int q = 0; q < 32; ++q) {
            const float4 a4 = *(const float4*)(arow + 8 * q);
            const float4 g4 = *(const float4*)(gp + 8 * q);
            const float b0 = brow[(size_t)(8 * q + 0) * NE], b1 = brow[(size_t)(8 * q + 1) * NE], b2 = brow[(size_t)(8 * q + 2) * NE], b3 = brow[(size_t)(8 * q + 3) * NE];
            acc = __builtin_amdgcn_mfma_f32_32x32x2f32(a4.x, b0 * g4.x, acc, 0, 0, 0);
            acc = __builtin_amdgcn_mfma_f32_32x32x2f32(a4.y, b1 * g4.y, acc, 0, 0, 0);
            acc = __builtin_amdgcn_mfma_f32_32x32x2f32(a4.z, b2 * g4.z, acc, 0, 0, 0);
            acc = __builtin_amdgcn_mfma_f32_32x32x2f32(a4.w, b3 * g4.w, acc, 0, 0, 0);
        }
#pragma unroll
        for (int r = 0; r < 16; ++r) part[(wid * 32 + (r & 3) + 8 * (r >> 2) + 4 * kk) * 32 + i32] = acc[r];
#pragma unroll 1
        for (int rr = 0; rr < 4; ++rr) {
            const int row = 4 * wid + rr, t = t0 + row;
            const float4* xr = (const float4*)(xmid + (size_t)t * D);
            float4 v[8]; float ss = 0.f;
#pragma unroll
            for (int i = 0; i < 8; ++i) { v[i] = xr[lane + 64 * i]; ss += v[i].x * v[i].x + v[i].y * v[i].y + v[i].z * v[i].z + v[i].w * v[i].w; }
            ss = wave_sum(ss);
            const float r = rsqrtf(ss * (1.0f / D) + EPS);
#pragma unroll
            for (int i = 0; i < 8; ++i) {
                const float4 gg = ((const float4*)g)[lane + 64 * i];
                *(unsigned*)((unsigned char*)h2b + (size_t)t * D + (lane + 64 * i) * 4) = pk4_fp8(v[i].x * r * gg.x, v[i].y * r * gg.y, v[i].z * r * gg.z, v[i].w * r * gg.w);
            }
            if (lane == 0) rs[row] = r;
        }
        __syncthreads();
#pragma unroll 1
        for (int rr = 0; rr < 4; ++rr) {
            const int row = 4 * wid + rr, t = t0 + row;
            float s = 0.f;
#pragma unroll
            for (int w = 0; w < 8; ++w) s += part[(w * 32 + row) * 32 + i32];
            s = s * rs[row] + rb[i32];
            unsigned usedmask = 0u; float mx = 0.f, sum = 0.f, myex = 0.f; int myid = 0;
#pragma unroll
            for (int k = 0; k < 4; ++k) {
                float bv = -3.4e38f; int bi = 0;
                for (int j = 0; j < 32; ++j) { const float vv = __shfl(s, j); if (!((usedmask >> j) & 1u) && vv > bv) { bv = vv; bi = j; } }
                usedmask |= 1u << bi;
                if (k == 0) mx = bv;
                const float ex = __expf(bv - mx); sum += ex;
                if (lane == k) { myex = ex; myid = bi; }
            }
            if (lane < 4) {
                asg_e[row * 4 + lane] = myid; asg_w[row * 4 + lane] = myex / sum;
                asg_r[row * 4 + lane] = __hip_atomic_fetch_add(lcnt + myid, 1, __ATOMIC_RELAXED, __HIP_MEMORY_SCOPE_WORKGROUP);
            }
        }
        __syncthreads();
        if (tz < NE) { const int c = lcnt[tz]; lbase[tz] = c ? atomicAdd(&counts[tz * CNT_STRIDE], c) : 0; lcnt[tz] = 0; }
        __syncthreads();
        if (tz < 128) {
            const int e = asg_e[tz], sl = lbase[e] + asg_r[tz], t = t0 + (tz >> 2);
            topi[t * 4 + (tz & 3)] = e; slot[t * 4 + (tz & 3)] = sl;
            listc[(size_t)e * T + sl] = t; rowwc[(size_t)e * T + sl] = asg_w[tz];
        }
        __syncthreads();
    }
}
__device__ __forceinline__ void build_tile_table(const int* __restrict__ counts, LAS int* tab) {
    if (threadIdx.x == 0) { int acc = 0; for (int e = 0; e < NE; ++e) { tab[e] = acc; acc += (__hip_atomic_load(&counts[e * CNT_STRIDE], __ATOMIC_RELAXED, __HIP_MEMORY_SCOPE_AGENT) + 255) >> 8; } tab[NE] = acc; }
    __syncthreads();
}
__device__ __forceinline__ int tile_expert(const LAS int* tab, int mt) { int e = 0;
#pragma unroll 1
    for (int j = 1; j < NE; ++j) if (tab[j] <= mt) e = j;
    return e; }

__device__ __forceinline__ void build_unit_desc(const LAS int* tab, int c, LAS int* ud) {
    const int t = threadIdx.x;
    if (t < 32) {
        const int x = c & 7, y = c >> 3, i = t & 15;
        const int mt = t < 16 ? 16 * i + 8 * (x & 1) + (y & 7) : 32 * i + 8 * (x & 3) + (y & 7);
        ud[t] = mt < tab[NE] ? ((tile_expert(tab, mt) << 16) | mt) : -1;
    }
    __syncthreads();
}
struct P6Policy {
    const char* h2b; const char* WguT; const int* listc; const float* bgu; bf16_t* act; const LAS int* tab; const LAS int* ud; int G, c, i0, icnt;
    static constexpr bool AVAR = true;
    static constexpr bool F8 = true;
    __device__ __forceinline__ int K() const { return D / 2; }
    __device__ __forceinline__ bool next(int ii, g8::Unit& u) const {
        if (ii >= icnt) return false;
        const int i = i0 + ii;
        const int x = c & 7, y = c >> 3;
        if (i >= 16) return false;
        const int ent = ud[i]; if (ent < 0) return false;
        const int mt = ent & 0xffff, e = ent >> 16, pn = 4 * (x >> 1) + (y >> 3);
        u.pm = mt; u.pn = pn; u.e = e; u.aux = mt - tab[e];
        u.A = h2b; u.B = WguT + ((size_t)e * 2 * F + 128 * pn) * D; return true;
    }
    __device__ __forceinline__ unsigned aoff(const g8::Unit& u, int h, int R) const {
        const int tok = listc[(size_t)u.e * T + 256 * u.aux + 128 * h + R] & (T - 1);
        return (unsigned)tok * (unsigned)D;
    }
    __device__ __forceinline__ unsigned boff(int h, int R) const { return (unsigned)((F * h + 32 * (R >> 5) + g8::perm32(R & 31)) * D); }
    __device__ __forceinline__ void epi(const f32x4 (&acc)[2][2][4][2], const g8::Unit& u, int wr, int wc, int fr, int fq) const {
        const int c0 = 128 * u.pn + 32 * wc + 8 * fq;
        const float* bg = bgu + (size_t)u.e * 2 * F + c0;
        const f32x4 bg0 = *(const f32x4*)bg, bg1 = *(const f32x4*)(bg + 4), bu0 = *(const f32x4*)(bg + F), bu1 = *(const f32x4*)(bg + F + 4);
        const int odd = fq & 1;
#pragma unroll
        for (int ai = 0; ai < 2; ++ai)
#pragma unroll
            for (int mp = 0; mp < 4; mp += 2) {
                const size_t row = (size_t)(256 * u.pm + 128 * ai + 64 * wr + 16 * (mp + odd) + fr);
                u32x2 w[2];
#pragma unroll
                for (int q = 0; q < 2; ++q) {
                    const int m = mp + q;
                    f32x4 o4[2];
#pragma unroll
                    for (int n = 0; n < 2; ++n) {
                        f32x4 gt = acc[ai][0][m][n] * WSCALE_INV + (n ? bg1 : bg0), up = acc[ai][1][m][n] * WSCALE_INV + (n ? bu1 : bu0);
#pragma unroll
                        for (int j = 0; j < 4; ++j) { gt[j] = fminf(gt[j], 7.0f); up[j] = fminf(fmaxf(up[j], -7.0f), 7.0f); }
                        f32x4 e = gt * (-1.702f * 1.4426950408889634f);
#pragma unroll
                        for (int j = 0; j < 4; ++j) e[j] = __builtin_amdgcn_exp2f(e[j]);
                        e = e + 1.0f;
#pragma unroll
                        for (int j = 0; j < 4; ++j) e[j] = __builtin_amdgcn_rcpf(e[j]);
                        o4[n] = ((up + 1.0f) * gt) * e;
                    }
                    w[q].x = pk4_fp8(o4[0][0], o4[0][1], o4[0][2], o4[0][3]); w[q].y = pk4_fp8(o4[1][0], o4[1][1], o4[1][2], o4[1][3]);
                }
                const auto r0 = __builtin_amdgcn_permlane16_swap(w[0].x, w[1].x, false, false), r1 = __builtin_amdgcn_permlane16_swap(w[0].y, w[1].y, false, false);
                u32x4 o; o.x = r0[0]; o.y = r1[0]; o.z = r0[1]; o.w = r1[1];
                *(u32x4*)((unsigned char*)act + row * F + c0 - 8 * odd) = o;
            }
    }
};
struct P7Policy {
    const char* actb; const char* WdnT; const float* rowwc; const float* bdn; bf16_t* yrow; const LAS int* tab; const LAS int* ud; int G, c;
    static constexpr bool AVAR = false;
    static constexpr bool F8 = true;
    __device__ __forceinline__ int K() const { return F / 2; }
    __device__ __forceinline__ bool next(int i, g8::Unit& u) const {
        const int x = c & 7, y = c >> 3;
        if (i >= 16) return false;
        const int ent = ud[16 + i]; if (ent < 0) return false;
        const int mt = ent & 0xffff, e = ent >> 16, pn = 4 * (x >> 2) + (y >> 3);
        u.pm = mt; u.pn = pn; u.e = e; u.aux = mt - tab[e];
        u.A = actb + (size_t)mt * 256 * F; u.B = WdnT + ((size_t)e * D + 256 * pn) * F; return true;
    }
    __device__ __forceinline__ unsigned aoff(const g8::Unit&, int h, int R) const { return (unsigned)((h * 128 + R) * F); }
    __device__ __forceinline__ unsigned boff(int h, int R) const { return (unsigned)((128 * h + 32 * (R >> 5) + g8::perm32(R & 31)) * F); }
    __device__ __forceinline__ void epi(const f32x4 (&acc)[2][2][4][2], const g8::Unit& u, int wr, int wc, int fr, int fq) const {
        float rw8[2][4]; f32x4 bb[2][2];
#pragma unroll
        for (int ai = 0; ai < 2; ++ai)
#pragma unroll
            for (int m = 0; m < 4; ++m) rw8[ai][m] = rowwc[(size_t)u.e * T + 256 * u.aux + 128 * ai + 64 * wr + 16 * m + fr];
#pragma unroll
        for (int bj = 0; bj < 2; ++bj) { const float* bp = bdn + (size_t)u.e * D + 256 * u.pn + 128 * bj + 32 * wc + 8 * fq; bb[bj][0] = *(const f32x4*)bp; bb[bj][1] = *(const f32x4*)(bp + 4); }
        const int odd = fq & 1;
#pragma unroll
        for (int ai = 0; ai < 2; ++ai)
#pragma unroll
            for (int mp = 0; mp < 4; mp += 2) {
                const size_t row = (size_t)(256 * u.pm + 128 * ai + 64 * wr + 16 * (mp + odd) + fr);
#pragma unroll
                for (int bj = 0; bj < 2; ++bj) {
                    const int c0 = 256 * u.pn + 128 * bj + 32 * wc + 8 * fq - 8 * odd;
                    const f32x4 b0 = bb[bj][0], b1 = bb[bj][1];
                    u32x2 w[2];
#pragma unroll
                    for (int q = 0; q < 2; ++q) {
                        const int m = mp + q;
                        const float rws = rw8[ai][m] * YSCALE;
                        const f32x4 v0 = (acc[ai][bj][m][0] * WSCALE_INV + b0) * rws, v1 = (acc[ai][bj][m][1] * WSCALE_INV + b1) * rws;
                        w[q].x = pk4_fp8(v0[0], v0[1], v0[2], v0[3]); w[q].y = pk4_fp8(v1[0], v1[1], v1[2], v1[3]);
                    }
                    const auto r0 = __builtin_amdgcn_permlane16_swap(w[0].x, w[1].x, false, false), r1 = __builtin_amdgcn_permlane16_swap(w[0].y, w[1].y, false, false);
                    u32x4 o; o.x = r0[0]; o.y = r1[0]; o.z = r0[1]; o.w = r1[1];
                    *(u32x4*)((unsigned char*)yrow + row * D + c0) = o;
                }
            }
    }
};
__device__ __forceinline__ void p8_final(const float* __restrict__ xmid, const bf16_t* __restrict__ yrow, const int* __restrict__ topi, const int* __restrict__ slot,
                                         const LAS int* tab, const float* __restrict__ g, float* __restrict__ out, int wg, int nwg) {
    const int tz = opaque_tid(), wid = tz >> 6, lane = tz & 63;
    for (int t = wg * 8 + wid; t < T; t += nwg * 8) {
        const float4* xr = (const float4*)(xmid + (size_t)t * D);
        float4 v[8];
#pragma unroll
        for (int i = 0; i < 8; ++i) v[i] = xr[lane + 64 * i];
#pragma unroll
        for (int k = 0; k < 4; ++k) {
            const int e = topi[t * 4 + k], sl = slot[t * 4 + k];
            const unsigned char* yr = (const unsigned char*)yrow + ((size_t)tab[e] * 256 + sl) * D;
#pragma unroll
            for (int i = 0; i < 8; ++i) {
                const unsigned w = *(const unsigned*)(yr + (lane + 64 * i) * 4);
                const auto lo = __builtin_amdgcn_cvt_pk_f32_fp8((int)w, false), hi = __builtin_amdgcn_cvt_pk_f32_fp8((int)w, true);
                v[i].x += lo[0] * YSCALE_INV; v[i].y += lo[1] * YSCALE_INV; v[i].z += hi[0] * YSCALE_INV; v[i].w += hi[1] * YSCALE_INV;
            }
        }
        float ss = 0.f;
#pragma unroll
        for (int i = 0; i < 8; ++i) ss += v[i].x * v[i].x + v[i].y * v[i].y + v[i].z * v[i].z + v[i].w * v[i].w;
        ss = wave_sum(ss);
        const float r = rsqrtf(ss * (1.0f / D) + EPS);
#pragma unroll
        for (int i = 0; i < 8; ++i) {
            const float4 gg = ((const float4*)g)[lane + 64 * i];
            float4 o; o.x = v[i].x * r * gg.x; o.y = v[i].y * r * gg.y; o.z = v[i].z * r * gg.z; o.w = v[i].w * r * gg.w;
            ((float4*)(out + (size_t)t * D))[lane + 64 * i] = o;
        }
    }
}

namespace mb {
using s16x4  = __attribute__((ext_vector_type(4))) short;
using f32x16 = __attribute__((ext_vector_type(16))) float;
constexpr int KVBLK = 64;
constexpr float SCALE = 0.088388347648318440f;
constexpr float THR = 8.f;
constexpr float NEG = -1e30f;
constexpr size_t SHM_V = KVBLK * 128 * 2, SHM_K = KVBLK * 128 * 2;
constexpr int NB = 4;
constexpr int OFF_K = NB * SHM_V, OFF_WS = NB * SHM_V + NB * SHM_K, OFF_KM = OFF_WS + 8 * 64 * 4;
constexpr int LDS_NEED = OFF_KM + 8 * 128 * 4;
#define MB_KSWZ(row, colB) ((row) * 256 + ((colB) ^ (((row) & 7) << 4)))
#define MB_SBAR() __builtin_amdgcn_sched_barrier(0)
__device__ __forceinline__ int crow(int r, int hi) { return (r & 3) + 8 * (r >> 2) + 4 * hi; }

__device__ __forceinline__ void partialSM(f32x16& p0, f32x16& p1, float& m_reg, float& mn, float& alpha, bool diag, bool keep, int lim) {
  typedef float f32x2_t __attribute__((ext_vector_type(2)));
  constexpr float C = SCALE * 1.4426950408889634f;
  if (diag) {
#pragma unroll
    for (int r = 0; r < 16; ++r) { const int kk = (r & 3) + 8 * (r >> 2); p0[r] = (kk <= lim) ? p0[r] : NEG; p1[r] = (kk + 32 <= lim) ? p1[r] : NEG; }
  }
  float pmax = p0[0];
#pragma unroll
  for (int r = 1; r < 16; ++r) pmax = fmaxf(pmax, p0[r]);
#pragma unroll
  for (int r = 0; r < 16; ++r) pmax = fmaxf(pmax, p1[r]);
  { auto rr = __builtin_amdgcn_permlane32_swap(__float_as_uint(pmax), __float_as_uint(pmax), false, false);
    pmax = fmaxf(__uint_as_float(rr[0]), __uint_as_float(rr[1])); }
  pmax = keep ? pmax : NEG;
  if (__builtin_expect(__all(pmax - m_reg <= THR / SCALE), 1)) { mn = m_reg; alpha = 1.f; }
  else { mn = fmaxf(m_reg, pmax); alpha = __builtin_amdgcn_exp2f((m_reg - mn) * C); m_reg = mn; }
  const float mnC = keep ? -mn * C : NEG;
  const f32x2_t c2 = {C, C}, m2 = {mnC, mnC};
#pragma unroll
  for (int r = 0; r < 16; r += 2) { f32x2_t v = {p0[r], p0[r + 1]}; v = __builtin_elementwise_fma(v, c2, m2); p0[r] = v[0]; p0[r + 1] = v[1]; }
#pragma unroll
  for (int r = 0; r < 16; r += 2) { f32x2_t v = {p1[r], p1[r + 1]}; v = __builtin_elementwise_fma(v, c2, m2); p1[r] = v[0]; p1[r + 1] = v[1]; }
#pragma unroll
  for (int r = 0; r < 16; ++r) p0[r] = __builtin_amdgcn_exp2f(p0[r]);
}
__device__ __forceinline__ void finishSM(f32x16& p0, f32x16& p1, float alpha, float& l_reg, bf16x8& pa0, bf16x8& pa1, bf16x8& pa2, bf16x8& pa3) {
  typedef float f32x2_t __attribute__((ext_vector_type(2)));
#pragma unroll
  for (int r = 0; r < 16; ++r) p1[r] = __builtin_amdgcn_exp2f(p1[r]);
  f32x2_t s2 = {0.f, 0.f};
#pragma unroll
  for (int r = 0; r < 16; r += 2) { const f32x2_t v = {p0[r], p0[r + 1]}; s2 += v; }
#pragma unroll
  for (int r = 0; r < 16; r += 2) { const f32x2_t v = {p1[r], p1[r + 1]}; s2 += v; }
  float ps = s2[0] + s2[1];
  { auto rr = __builtin_amdgcn_permlane32_swap(__float_as_uint(ps), __float_as_uint(ps), false, false);
    ps = __uint_as_float(rr[0]) + __uint_as_float(rr[1]); }
  l_reg = l_reg * alpha + ps;
#define MB_PK4(P, BASE, OUT) do { unsigned a0 = cvt_pk_bf16(P[BASE + 0], P[BASE + 1]), a1 = cvt_pk_bf16(P[BASE + 2], P[BASE + 3]);   \
    unsigned b0 = cvt_pk_bf16(P[BASE + 4], P[BASE + 5]), b1 = cvt_pk_bf16(P[BASE + 6], P[BASE + 7]);                              \
    auto r0 = __builtin_amdgcn_permlane32_swap(a0, b0, false, false); auto r1 = __builtin_amdgcn_permlane32_swap(a1, b1, false, false); \
    u32x4 w = {r0[0], r1[0], r0[1], r1[1]}; OUT = *reinterpret_cast<bf16x8*>(&w); } while (0)
  MB_PK4(p0, 0, pa0); MB_PK4(p0, 8, pa1); MB_PK4(p1, 0, pa2); MB_PK4(p1, 8, pa3);
#undef MB_PK4
}
__device__ __forceinline__ void qkt(f32x16& p0, f32x16& p1, const LAS char* Ks, const bf16x8* qr, int r32, int hi) {
  p0 = f32x16{}; p1 = f32x16{};
#pragma unroll
  for (int d0 = 0; d0 < 8; ++d0) { int cb = (d0 * 16 + hi * 8) * 2;
    bf16x8 b0 = *reinterpret_cast<const LAS bf16x8*>(Ks + MB_KSWZ(r32, cb));
    bf16x8 b1 = *reinterpret_cast<const LAS bf16x8*>(Ks + MB_KSWZ(32 + r32, cb));
    p0 = __builtin_amdgcn_mfma_f32_32x32x16_bf16(b0, qr[d0], p0, 0, 0, 0);
    p1 = __builtin_amdgcn_mfma_f32_32x32x16_bf16(b1, qr[d0], p1, 0, 0, 0); }
}
__device__ __forceinline__ int v_st(int k, int c) { const int kk = (k & ~0xC) | ((k & 4) << 1) | ((k & 8) >> 1); return ((kk >> 3) * 4 + (c >> 5)) * 512 + ((kk & 7) * 32 + (c & 31)) * 2; }
__device__ __forceinline__ int v_rd_base(int lane) { return ((lane & 3) << 3) | (((lane >> 2) & 3) << 6) | (((lane >> 4) & 1) << 5) | (((lane >> 5) & 1) << 8); }
constexpr int v_rd_off(int d0, int ks, int half) { return d0 * 512 + ks * 4096 + half * 2048; }
template <int OFF> __device__ __forceinline__ s16x4 tr_read(int vb) {
  s16x4 r; asm volatile("ds_read_b64_tr_b16 %0, %1 offset:%2" : "=&v"(r) : "v"(vb), "i"(OFF) : "memory"); return r;
}
template <int D0> __device__ __forceinline__ void pv_one(f32x16& od, int vb, bf16x8 pa0, bf16x8 pa1, bf16x8 pa2, bf16x8 pa3) {
  const s16x4 l0 = tr_read<v_rd_off(D0, 0, 0)>(vb), h0 = tr_read<v_rd_off(D0, 0, 1)>(vb), l1 = tr_read<v_rd_off(D0, 1, 0)>(vb), h1 = tr_read<v_rd_off(D0, 1, 1)>(vb);
  const s16x4 l2 = tr_read<v_rd_off(D0, 2, 0)>(vb), h2 = tr_read<v_rd_off(D0, 2, 1)>(vb), l3 = tr_read<v_rd_off(D0, 3, 0)>(vb), h3 = tr_read<v_rd_off(D0, 3, 1)>(vb);
  asm volatile("s_waitcnt lgkmcnt(0)" ::: "memory"); MB_SBAR();
#define MB_PK(L, H) (bf16x8){L[0], L[1], L[2], L[3], H[0], H[1], H[2], H[3]}
  od = __builtin_amdgcn_mfma_f32_32x32x16_bf16(pa0, MB_PK(l0, h0), od, 0, 0, 0);
  od = __builtin_amdgcn_mfma_f32_32x32x16_bf16(pa1, MB_PK(l1, h1), od, 0, 0, 0);
  od = __builtin_amdgcn_mfma_f32_32x32x16_bf16(pa2, MB_PK(l2, h2), od, 0, 0, 0);
  od = __builtin_amdgcn_mfma_f32_32x32x16_bf16(pa3, MB_PK(l3, h3), od, 0, 0, 0);
#undef MB_PK
}
__device__ __forceinline__ void pv_d0(f32x16* o, int vb, bf16x8 pa0, bf16x8 pa1, bf16x8 pa2, bf16x8 pa3) {
  pv_one<0>(o[0], vb, pa0, pa1, pa2, pa3); pv_one<1>(o[1], vb, pa0, pa1, pa2, pa3); pv_one<2>(o[2], vb, pa0, pa1, pa2, pa3); pv_one<3>(o[3], vb, pa0, pa1, pa2, pa3);
}

__device__ __forceinline__ void moba_item(const bf16_t* __restrict__ projb, const float* __restrict__ kpart, bf16_t* __restrict__ omoba, int b, int h, int cur, LAS char* lds) {
  constexpr long LD = INW;
  const int tid = opaque_tid(), wid = tid >> 6, lane = tid & 63, r32 = lane & 31, hi = lane >> 5;
  const bf16_t* Qb = projb + ((long)(b * S + cur * MBLK)) * LD + C_MQ + h * 128;
  const bf16_t* Kh = projb + ((long)(b * S)) * LD + C_MK + h * 128;
  const bf16_t* Vh = projb + ((long)(b * S)) * LD + C_MV + h * 128;
  LAS char* V_lds = lds; LAS char* K_lds = lds + OFF_K;
  LAS float* wsl = (LAS float*)(lds + OFF_WS) + wid * 64; LAS float* li_l = wsl; LAS float* al_l = wsl + 32;
  LAS float* km = (LAS float*)(lds + OFF_KM);
  __syncthreads();
  for (int i = tid; i < cur * 128; i += 512) { const int j = i >> 7, d = i & 127; const int pm = b * 8 + j;
    km[i] = (kpart[(size_t)(pm * 2) * 2048 + h * 128 + d] + kpart[(size_t)(pm * 2 + 1) * 2048 + h * 128 + d]) * (1.0f / MBLK); }
  float m_reg = -1e30f, l_reg = 0; f32x16 o[4] = {}; bf16x8 qr[8];
  const bf16_t* Qw = Qb + (long)(wid * 32 + r32) * LD + hi * 8;
#pragma unroll
  for (int d0 = 0; d0 < 8; ++d0) qr[d0] = *reinterpret_cast<const bf16x8*>(Qw + d0 * 16);
  const int widu = __builtin_amdgcn_readfirstlane(wid);
  const int krow = wid * 8 + (lane >> 4);
  const int koff0 = krow * (int)(LD * 2) + (((lane & 15) ^ (krow & 7)) << 4), koff1 = (krow + 4) * (int)(LD * 2) + (((lane & 15) ^ ((krow + 4) & 7)) << 4);
  const int kkv = wid * 8 + ((lane >> 2) & 7), kpv = (kkv & ~0xC) | ((kkv & 4) << 1) | ((kkv & 8) >> 1);
  const int voff0 = kpv * (int)(LD * 2) + (((lane >> 5) * 32 + (lane & 3) * 8) << 1), voff1 = voff0 + 128;
#define MB_K0(t) ((((t) >> 2) == 0 ? cur : ((t) >> 2) - 1) * MBLK + ((t) & 3) * KVBLK)
#define MB_DMA(t) do { const int t_ = (t); const long k0_ = MB_K0(t_); const int bb_ = t_ & 3;                                           \
    const char* kg_ = (const char*)(Kh + k0_ * LD); const char* vg_ = (const char*)(Vh + k0_ * LD);                                       \
    LAS char* kd_ = K_lds + bb_ * SHM_K + widu * 2048; LAS char* vd_ = V_lds + bb_ * SHM_V + widu * 2048;                                 \
    __builtin_amdgcn_global_load_lds((const unsigned*)(kg_ + koff0), (LAS unsigned*)kd_, 16, 0, 0);                                       \
    __builtin_amdgcn_global_load_lds((const unsigned*)(kg_ + koff1), (LAS unsigned*)(kd_ + 1024), 16, 0, 0);                              \
    __builtin_amdgcn_global_load_lds((const unsigned*)(vg_ + voff0), (LAS unsigned*)vd_, 16, 0, 0);                                       \
    __builtin_amdgcn_global_load_lds((const unsigned*)(vg_ + voff1), (LAS unsigned*)(vd_ + 1024), 16, 0, 0); } while (0)
  MB_DMA(0); MB_DMA(1); MB_DMA(2);
  __syncthreads();
  unsigned selmask = 0u;
  if (cur > 0) {
    float g[7];
#pragma unroll
    for (int j = 0; j < 7; ++j) {
      float s = 0.f;
      if (j < cur) {
#pragma unroll
        for (int d0 = 0; d0 < 8; ++d0) {
          const f32x4 k0 = *(const LAS f32x4*)(km + j * 128 + d0 * 16 + hi * 8), k1 = *(const LAS f32x4*)(km + j * 128 + d0 * 16 + hi * 8 + 4);
          const bf16x8 q = qr[d0];
          s += __uint_as_float(((unsigned)(unsigned short)q[0]) << 16) * k0[0] + __uint_as_float(((unsigned)(unsigned short)q[1]) << 16) * k0[1]
             + __uint_as_float(((unsigned)(unsigned short)q[2]) << 16) * k0[2] + __uint_as_float(((unsigned)(unsigned short)q[3]) << 16) * k0[3]
             + __uint_as_float(((unsigned)(unsigned short)q[4]) << 16) * k1[0] + __uint_as_float(((unsigned)(unsigned short)q[5]) << 16) * k1[1]
             + __uint_as_float(((unsigned)(unsigned short)q[6]) << 16) * k1[2] + __uint_as_float(((unsigned)(unsigned short)q[7]) << 16) * k1[3];
        }
        s += __shfl_xor(s, 32);
      } else s = -3.0e38f;
      g[j] = s;
    }
#pragma unroll
    for (int j = 0; j < 7; ++j) {
      int rank = 0;
#pragma unroll
      for (int i = 0; i < 7; ++i) if (i != j) rank += (g[i] > g[j] || (g[i] == g[j] && i < j)) ? 1 : 0;
      if (j < cur && rank < 3) selmask |= 1u << j;
    }
  }
  const int qi = wid * 32 + r32;
  const int vb0 = (int)(uintptr_t)V_lds + v_rd_base(lane);
  const int NT = 4 * (cur + 1);
#define MB_WAIT(more) do { if (more) asm volatile("s_waitcnt vmcnt(4)" ::: "memory"); else asm volatile("s_waitcnt vmcnt(0)" ::: "memory"); } while (0)
#define MB_RESC(a) do { if (__any((a) < 1.f)) { if (hi == 0) al_l[r32] = (a); asm volatile("s_waitcnt lgkmcnt(0)" ::: "memory"); \
    _Pragma("unroll") for (int d = 0; d < 4; ++d) _Pragma("unroll") for (int r = 0; r < 16; ++r) o[d][r] *= al_l[crow(r, hi)]; } } while (0)
#define MB_MASKP(t, DG, KP, LM) const bool DG = ((t) >> 2) == 0; const bool KP = DG ? true : (((selmask >> (((t) >> 2) - 1)) & 1u) != 0u); const int LM = qi - ((t) & 3) * KVBLK - 4 * hi;
  f32x16 pA0, pA1, pB0, pB1; float mnA, mnB, alA, alB; bf16x8 pa0, pa1, pa2, pa3;
  asm volatile("s_waitcnt vmcnt(0)" ::: "memory"); __syncthreads();
  { MB_MASKP(0, dg, kp, lm); qkt(pA0, pA1, K_lds, qr, r32, hi); partialSM(pA0, pA1, m_reg, mnA, alA, dg, kp, lm); }
  const int wact = widu >> 1;
#define MB_ACT(t) ((t) > 3 || (t) <= wact)
  for (int j = 1; j + 1 < NT; j += 2) {
    const bool more1 = j + 2 < NT, more2 = j + 3 < NT;
    const bool actP = MB_ACT(j - 1), actC = MB_ACT(j), actN = MB_ACT(j + 1);
    if (more1) MB_DMA(j + 2);
    MB_SBAR(); if (actC) qkt(pB0, pB1, K_lds + (j & 3) * SHM_K, qr, r32, hi);
    if (actP) finishSM(pA0, pA1, alA, l_reg, pa0, pa1, pa2, pa3);
    MB_SBAR();
    if (actP) pv_d0(o, vb0 + ((j - 1) & 3) * (int)SHM_V, pa0, pa1, pa2, pa3);
    if (actC) { MB_MASKP(j, dg, kp, lm); partialSM(pB0, pB1, m_reg, mnB, alB, dg, kp, lm); MB_RESC(alB); }
    MB_WAIT(more1); __syncthreads();
    if (more2) MB_DMA(j + 3);
    MB_SBAR(); if (actN) qkt(pA0, pA1, K_lds + ((j + 1) & 3) * SHM_K, qr, r32, hi);
    if (actC) finishSM(pB0, pB1, alB, l_reg, pa0, pa1, pa2, pa3);
    MB_SBAR();
    if (actC) pv_d0(o, vb0 + (j & 3) * (int)SHM_V, pa0, pa1, pa2, pa3);
    if (actN) { MB_MASKP(j + 1, dg, kp, lm); partialSM(pA0, pA1, m_reg, mnA, alA, dg, kp, lm); MB_RESC(alA); }
    MB_WAIT(more2); __syncthreads();
  }
  {
    const bool actP = MB_ACT(NT - 2), actC = MB_ACT(NT - 1);
    MB_SBAR(); if (actC) qkt(pB0, pB1, K_lds + ((NT - 1) & 3) * SHM_K, qr, r32, hi);
    if (actP) finishSM(pA0, pA1, alA, l_reg, pa0, pa1, pa2, pa3);
    MB_SBAR();
    if (actP) pv_d0(o, vb0 + ((NT - 2) & 3) * (int)SHM_V, pa0, pa1, pa2, pa3);
    if (actC) {
      { MB_MASKP(NT - 1, dg, kp, lm); partialSM(pB0, pB1, m_reg, mnB, alB, dg, kp, lm); }
      MB_RESC(alB);
      finishSM(pB0, pB1, alB, l_reg, pa0, pa1, pa2, pa3); MB_SBAR();
      pv_d0(o, vb0 + ((NT - 1) & 3) * (int)SHM_V, pa0, pa1, pa2, pa3);
    }
  }
#undef MB_ACT
  if (hi == 0) li_l[r32] = l_reg; asm volatile("s_waitcnt lgkmcnt(0)" ::: "memory");
  float rli[16];
#pragma unroll
  for (int r = 0; r < 16; ++r) rli[r] = __builtin_amdgcn_rcpf(li_l[crow(r, hi)]);
  { const int t2 = opaque_tid(), w2 = t2 >> 6, r2 = t2 & 31, h2 = (t2 >> 5) & 1;
    bf16_t* Ow = omoba + ((long)(b * S + cur * MBLK + w2 * 32)) * D + h * 128 + r2;
#pragma unroll
    for (int r = 0; r < 16; ++r) { const int orow = crow(r, h2);
#pragma unroll
      for (int d0 = 0; d0 < 4; ++d0) { const float v = o[d0][r] * rli[r]; Ow[(long)orow * D + d0 * 32] = (bf16_t)(cvt_pk_bf16(v, v) & 0xffffu); } } }
#undef MB_K0
#undef MB_DMA
#undef MB_WAIT
#undef MB_RESC
#undef MB_MASKP
}
}

namespace rt {
using mb::f32x16; using mb::s16x4;
constexpr int RP = 272, R0 = 0, R1 = 34816, R2 = 69632, R3 = 104448;
constexpr int OPITCH = 528;
__device__ __forceinline__ bf16x8 scale8(bf16x8 v, float f) {
    u32x4 w;
    w.x = cvt_pk_bf16(__uint_as_float(((unsigned)(unsigned short)v[0]) << 16) * f, __uint_as_float(((unsigned)(unsigned short)v[1]) << 16) * f);
    w.y = cvt_pk_bf16(__uint_as_float(((unsigned)(unsigned short)v[2]) << 16) * f, __uint_as_float(((unsigned)(unsigned short)v[3]) << 16) * f);
    w.z = cvt_pk_bf16(__uint_as_float(((unsigned)(unsigned short)v[4]) << 16) * f, __uint_as_float(((unsigned)(unsigned short)v[5]) << 16) * f);
    w.w = cvt_pk_bf16(__uint_as_float(((unsigned)(unsigned short)v[6]) << 16) * f, __uint_as_float(((unsigned)(unsigned short)v[7]) << 16) * f);
    return *reinterpret_cast<bf16x8*>(&w);
}
#define RT_PK(L, H) (bf16x8){L[0], L[1], L[2], L[3], H[0], H[1], H[2], H[3]}
template <int TH, int KS, bool FULL>
__device__ __forceinline__ void cd_step(f32x16 (&O)[4], f32x16 (&Z)[4], LAS char* lds, int vbase, int ktbase, int r32, int hi) {
    constexpr int s = TH * 4 + KS;
    const s16x4 vl = mb::tr_read<mb::v_rd_off(0, KS, 0)>(vbase), vh = mb::tr_read<mb::v_rd_off(0, KS, 1)>(vbase);
    const s16x4 k0l = mb::tr_read<mb::v_rd_off(0, KS, 0)>(ktbase), k0h = mb::tr_read<mb::v_rd_off(0, KS, 1)>(ktbase);
    const s16x4 k1l = mb::tr_read<mb::v_rd_off(1, KS, 0)>(ktbase), k1h = mb::tr_read<mb::v_rd_off(1, KS, 1)>(ktbase);
    const s16x4 k2l = mb::tr_read<mb::v_rd_off(2, KS, 0)>(ktbase), k2h = mb::tr_read<mb::v_rd_off(2, KS, 1)>(ktbase);
    const s16x4 k3l = mb::tr_read<mb::v_rd_off(3, KS, 0)>(ktbase), k3h = mb::tr_read<mb::v_rd_off(3, KS, 1)>(ktbase);
    bf16x8 sa[4];
    if constexpr (FULL) {
#pragma unroll
        for (int I = s >> 1; I < 4; ++I) sa[I] = *reinterpret_cast<const LAS bf16x8*>(lds + R2 + ((32 * I + r32) * RP + (16 * s + 8 * hi) * 2));
    }
    asm volatile("s_waitcnt lgkmcnt(0)" ::: "memory"); MB_SBAR();
    const bf16x8 bv = RT_PK(vl, vh);
    if constexpr (FULL) {
#pragma unroll
        for (int I = s >> 1; I < 4; ++I) O[I] = __builtin_amdgcn_mfma_f32_32x32x16_bf16(sa[I], bv, O[I], 0, 0, 0);
    }
    Z[0] = __builtin_amdgcn_mfma_f32_32x32x16_bf16(RT_PK(k0l, k0h), bv, Z[0], 0, 0, 0);
    Z[1] = __builtin_amdgcn_mfma_f32_32x32x16_bf16(RT_PK(k1l, k1h), bv, Z[1], 0, 0, 0);
    Z[2] = __builtin_amdgcn_mfma_f32_32x32x16_bf16(RT_PK(k2l, k2h), bv, Z[2], 0, 0, 0);
    Z[3] = __builtin_amdgcn_mfma_f32_32x32x16_bf16(RT_PK(k3l, k3h), bv, Z[3], 0, 0, 0);
}
#define RT_IDS(tz, lane, r32, hi, sr, sc) int tz = threadIdx.x; asm volatile("" : "+v"(tz)); const int lane = tz & 63, r32 = lane & 31, hi = lane >> 5, sr = tz >> 4, sc = (tz & 15) * 8; (void)sr; (void)sc; (void)r32; (void)hi;
struct Pf { bf16x8 k[4], q[4], v[8]; };
__device__ __forceinline__ void pf_load_k(Pf& pf, const bf16_t* __restrict__ Kg, int t0) { constexpr long LD = INW; RT_IDS(tz, lane, r32, hi, sr, sc)
#pragma unroll
    for (int i = 0; i < 4; ++i) pf.k[i] = *reinterpret_cast<const bf16x8*>(Kg + (long)(t0 + sr + 32 * i) * LD + sc); }
__device__ __forceinline__ void pf_load_q(Pf& pf, const bf16_t* __restrict__ Qg, int t0) { constexpr long LD = INW; RT_IDS(tz, lane, r32, hi, sr, sc)
#pragma unroll
    for (int i = 0; i < 4; ++i) pf.q[i] = *reinterpret_cast<const bf16x8*>(Qg + (long)(t0 + sr + 32 * i) * LD + sc); }
__device__ __forceinline__ void pf_load_v(Pf& pf, const bf16_t* __restrict__ Vg, int t0) { constexpr long LD = INW; RT_IDS(tz, lane, r32, hi, sr, sc)
#pragma unroll
    for (int i = 0; i < 4; ++i)
#pragma unroll
        for (int q = 0; q < 2; ++q) pf.v[2 * i + q] = *reinterpret_cast<const bf16x8*>(Vg + (long)(t0 + sr + 32 * i) * LD + 128 * q + sc); }
__device__ __forceinline__ void pf_write_v(const Pf& pf, LAS char* lds) { RT_IDS(tz, lane, r32, hi, sr, sc)
#pragma unroll
    for (int i = 0; i < 4; ++i) { const int row = sr + 32 * i;
#pragma unroll
        for (int q = 0; q < 2; ++q) *(LAS bf16x8*)(lds + ((row >> 6) ? R1 : R0) + q * 16384 + mb::v_st(row & 63, sc)) = pf.v[2 * i + q]; } }
template <bool full>
__device__ __forceinline__ void ret_chunk(f32x16 (&Z)[4], Pf& pf, const bf16_t* __restrict__ Qg, const bf16_t* __restrict__ Kg, const bf16_t* __restrict__ Vg, const bf16_t* __restrict__ Gg,
                                          bf16_t* __restrict__ oretb, int b, int h, int c, int nxt, float lg2, float cd, int wid, LAS char* lds) {
    constexpr long LD = INW;
    const int hd = wid >> 2, d0 = wid & 3;
    {
        const int t0 = c * 128;
        f32x16 O[4] = {};
        __syncthreads();

        {
            RT_IDS(tz, lane, r32, hi, sr, sc)
#pragma unroll
            for (int i = 0; i < 4; ++i) {
                const int row = sr + 32 * i;
                const bf16x8 ks = scale8(pf.k[i], exp2f(-(float)row * lg2));
                *(LAS bf16x8*)(lds + R3 + (row >> 6) * 16384 + mb::v_st(row & 63, sc)) = ks;
                if constexpr (full) {
                    *(LAS bf16x8*)(lds + R0 + (row * RP + sc * 2)) = ks;
                    *(LAS bf16x8*)(lds + R1 + (row * RP + sc * 2)) = scale8(pf.q[i], exp2f((float)row * lg2));
                }
            }
        }
        if constexpr (full) pf_load_v(pf, Vg, t0);
        else {
            pf_write_v(pf, lds);
            if (nxt) pf_load_k(pf, Kg, t0 + 128);
            if (nxt == 1) pf_load_v(pf, Vg, t0 + 128);
            if (nxt == 2) pf_load_q(pf, Qg, t0 + 128);
        }
#pragma unroll
        for (int d = 0; d < 4; ++d)
#pragma unroll
            for (int r = 0; r < 16; ++r) Z[d][r] *= cd;
        if constexpr (full) {
            __syncthreads();
            {
                RT_IDS(tz, lane, r32, hi, sr, sc)
                for (int ti = wid; ti < 10; ti += 8) {
                    int I, J;
                    if (ti == 0) { I = 0; J = 0; } else if (ti < 3) { I = 1; J = ti - 1; } else if (ti < 6) { I = 2; J = ti - 3; } else { I = 3; J = ti - 6; }
                    f32x16 sacc = {};
                    const LAS char* kap = lds + R0 + (32 * J + r32) * RP + 16 * hi;
                    const LAS char* qbp = lds + R1 + (32 * I + r32) * RP + 16 * hi;
#pragma unroll
                    for (int s = 0; s < 8; ++s) {
                        const bf16x8 ka = *reinterpret_cast<const LAS bf16x8*>(kap + 32 * s);
                        const bf16x8 qb = *reinterpret_cast<const LAS bf16x8*>(qbp + 32 * s);
                        sacc = __builtin_amdgcn_mfma_f32_32x32x16_bf16(ka, qb, sacc, 0, 0, 0);
                    }
                    LAS char* wp = lds + R2 + (32 * I + r32) * RP + (32 * J + 4 * hi) * 2;
                    const int lim = (I == J) ? r32 - 4 * hi : 1000;
#pragma unroll
                    for (int g = 0; g < 4; ++g) {
                        float v[4];
#pragma unroll
                        for (int q = 0; q < 4; ++q) v[q] = (8 * g + q > lim) ? 0.f : sacc[4 * g + q];
                        u32x2 w; w.x = cvt_pk_bf16(v[0], v[1]); w.y = cvt_pk_bf16(v[2], v[3]);
                        *(LAS u32x2*)(wp + 16 * g) = w;
                    }
                }
            }
            {
                RT_IDS(tz, lane, r32, hi, sr, sc)
                const LAS char* qp = lds + R1 + r32 * RP + 8 * hi;
#pragma unroll
                for (int s = 0; s < 8; ++s) {
                    const int dkt = s >> 1, sub = s & 1;
                    u32x4 zw;
                    zw.x = cvt_pk_bf16(Z[dkt][8 * sub + 0], Z[dkt][8 * sub + 1]); zw.y = cvt_pk_bf16(Z[dkt][8 * sub + 2], Z[dkt][8 * sub + 3]);
                    zw.z = cvt_pk_bf16(Z[dkt][8 * sub + 4], Z[dkt][8 * sub + 5]); zw.w = cvt_pk_bf16(Z[dkt][8 * sub + 6], Z[dkt][8 * sub + 7]);
                    const bf16x8 bz = *reinterpret_cast<bf16x8*>(&zw);
#pragma unroll
                    for (int I = 0; I < 4; ++I) {
                        const u32x2 a0 = *(const LAS u32x2*)(qp + 32 * I * RP + 32 * s);
                        const u32x2 a1 = *(const LAS u32x2*)(qp + 32 * I * RP + 32 * s + 16);
                        u32x4 aw = {a0.x, a0.y, a1.x, a1.y};
                        O[I] = __builtin_amdgcn_mfma_f32_32x32x16_bf16(*reinterpret_cast<bf16x8*>(&aw), bz, O[I], 0, 0, 0);
                    }
                    MB_SBAR();
                }
            }
            __syncthreads();
            pf_write_v(pf, lds);
            if (nxt) { pf_load_k(pf, Kg, t0 + 128); pf_load_q(pf, Qg, t0 + 128); }
        }
        __syncthreads();
        {
            RT_IDS(tz, lane, r32, hi, sr, sc)
            const int vb0 = (int)(uintptr_t)(lds + R0) + hd * 16384 + d0 * 512 + mb::v_rd_base(lane);
            const int vb1 = vb0 + (R1 - R0);
            const int kt0 = (int)(uintptr_t)(lds + R3) + mb::v_rd_base(lane);
            const int kt1 = kt0 + 16384;
            if constexpr (full) {
                cd_step<0, 0, true>(O, Z, lds, vb0, kt0, r32, hi); cd_step<0, 1, true>(O, Z, lds, vb0, kt0, r32, hi); cd_step<0, 2, true>(O, Z, lds, vb0, kt0, r32, hi); cd_step<0, 3, true>(O, Z, lds, vb0, kt0, r32, hi);
                cd_step<1, 0, true>(O, Z, lds, vb1, kt1, r32, hi); cd_step<1, 1, true>(O, Z, lds, vb1, kt1, r32, hi); cd_step<1, 2, true>(O, Z, lds, vb1, kt1, r32, hi); cd_step<1, 3, true>(O, Z, lds, vb1, kt1, r32, hi);
            } else {
                cd_step<0, 0, false>(O, Z, lds, vb0, kt0, r32, hi); cd_step<0, 1, false>(O, Z, lds, vb0, kt0, r32, hi); cd_step<0, 2, false>(O, Z, lds, vb0, kt0, r32, hi); cd_step<0, 3, false>(O, Z, lds, vb0, kt0, r32, hi);
                cd_step<1, 0, false>(O, Z, lds, vb1, kt1, r32, hi); cd_step<1, 1, false>(O, Z, lds, vb1, kt1, r32, hi); cd_step<1, 2, false>(O, Z, lds, vb1, kt1, r32, hi); cd_step<1, 3, false>(O, Z, lds, vb1, kt1, r32, hi);
            }
        }
        if constexpr (full) {
            __syncthreads();
            u32x4 gw[8];
            {
                RT_IDS(tz, lane, r32, hi, sr, sc)
                const bf16_t* gp = Gg + (long)(t0 + (tz >> 2)) * LD + 64 * (tz & 3);
#pragma unroll
                for (int i = 0; i < 8; ++i) gw[i] = *(const u32x4*)(gp + 8 * i);
            }
            {
                RT_IDS(tz, lane, r32, hi, sr, sc)
                LAS char* op = lds + R2 + (4 * hi) * OPITCH + (32 * wid + r32) * 2;
#pragma unroll
                for (int I = 0; I < 4; ++I)
#pragma unroll
                    for (int r = 0; r < 16; ++r)
                        *(LAS bf16_t*)(op + (32 * I + (r & 3) + 8 * (r >> 2)) * OPITCH) = (bf16_t)(cvt_pk_bf16(O[I][r], O[I][r]) & 0xffffu);
            }
            __syncthreads();
            {
                RT_IDS(tz, lane, r32, hi, sr, sc)
                const int row = tz >> 2, q = tz & 3;
                const LAS char* op = lds + R2 + row * OPITCH + q * 128;
                u32x4 ov[8]; float ss = 0.f;
#pragma unroll
                for (int i = 0; i < 8; ++i) { ov[i] = *(const LAS u32x4*)(op + 16 * i);
                    const float a0 = bf_lo(ov[i].x), a1 = bf_hi(ov[i].x), a2 = bf_lo(ov[i].y), a3 = bf_hi(ov[i].y), a4 = bf_lo(ov[i].z), a5 = bf_hi(ov[i].z), a6 = bf_lo(ov[i].w), a7 = bf_hi(ov[i].w);
                    ss += a0 * a0 + a1 * a1 + a2 * a2 + a3 * a3 + a4 * a4 + a5 * a5 + a6 * a6 + a7 * a7; }
                ss += __shfl_xor(ss, 1); ss += __shfl_xor(ss, 2);
                const float rs = rsqrtf(ss * (1.0f / 256.0f) + EPS);
                const long t = (long)(b * S + t0 + row);
                bf16_t* dp = oretb + t * D + h * 256 + 64 * q;
#pragma unroll
                for (int i = 0; i < 8; ++i) {
                    u32x4 w;
                    w.x = cvt_pk_bf16(bf_lo(ov[i].x) * rs * bf_lo(gw[i].x), bf_hi(ov[i].x) * rs * bf_hi(gw[i].x));
                    w.y = cvt_pk_bf16(bf_lo(ov[i].y) * rs * bf_lo(gw[i].y), bf_hi(ov[i].y) * rs * bf_hi(gw[i].y));
                    w.z = cvt_pk_bf16(bf_lo(ov[i].z) * rs * bf_lo(gw[i].z), bf_hi(ov[i].z) * rs * bf_hi(gw[i].z));
                    w.w = cvt_pk_bf16(bf_lo(ov[i].w) * rs * bf_lo(gw[i].w), bf_hi(ov[i].w) * rs * bf_hi(gw[i].w));
                    *(u32x4*)(dp + 8 * i) = w;
                }
            }
        }
    }
}
__device__ __forceinline__ void ret_item(const bf16_t* __restrict__ projb, bf16_t* __restrict__ oretb, int b, int h, int seg, LAS char* lds) {
    constexpr long LD = INW;
    const int wid = __builtin_amdgcn_readfirstlane(threadIdx.x >> 6);
    const float lg2 = log2f(1.0f - exp2f(-5.0f - (float)h));
    const float cd = exp2f(128.0f * lg2);
    const bf16_t* Qg = projb + (long)(b * S) * LD + C_RQ + h * 128;
    const bf16_t* Kg = projb + (long)(b * S) * LD + C_RK + h * 128;
    const bf16_t* Vg = projb + (long)(b * S) * LD + C_RV + h * 256;
    const bf16_t* Gg = projb + (long)(b * S) * LD + C_RG + h * 256;
    f32x16 Z[4] = {};
    Pf pf;
    pf_load_k(pf, Kg, 0);
    if (seg > 0) pf_load_v(pf, Vg, 0); else pf_load_q(pf, Qg, 0);
    for (int c = 0; c < 4 * seg; ++c) ret_chunk<false>(Z, pf, Qg, Kg, Vg, Gg, oretb, b, h, c, c + 1 < 4 * seg ? 1 : 2, lg2, cd, wid, lds);
    for (int c = 4 * seg; c < 4 * seg + 4; ++c) ret_chunk<true>(Z, pf, Qg, Kg, Vg, Gg, oretb, b, h, c, c + 1 < 4 * seg + 4 ? 2 : 0, lg2, cd, wid, lds);
    __syncthreads();
}
#undef RT_IDS
#undef RT_PK
}


__device__ __forceinline__ void p2_item(int q, const bf16_t* projb, const float* kpart, bf16_t* omobab, bf16_t* oretb, LAS char* lds) {
    int kind, lvl, bh;
    if (q < 64) { kind = 0; lvl = 7; bh = q; } else if (q < 128) { kind = 0; lvl = 6; bh = q - 64; } else if (q < 160) { kind = 1; lvl = 3; bh = q - 128; }
    else if (q < 224) { kind = 0; lvl = 5; bh = q - 160; } else if (q < 256) { kind = 1; lvl = 2; bh = q - 224; } else if (q < 320) { kind = 0; lvl = 4; bh = q - 256; }
    else if (q < 352) { kind = 1; lvl = 1; bh = q - 320; } else if (q < 416) { kind = 0; lvl = 3; bh = q - 352; } else if (q < 448) { kind = 1; lvl = 0; bh = q - 416; }
    else if (q < 512) { kind = 0; lvl = 2; bh = q - 448; } else if (q < 576) { kind = 0; lvl = 1; bh = q - 512; } else { kind = 0; lvl = 0; bh = q - 576; }
    if (kind == 0) mb::moba_item(projb, kpart, omobab, bh / MH, bh % MH, lvl, lds);
    else rt::ret_item(projb, oretb, bh / RH, bh % RH, lvl, lds);
}
constexpr int P2_ITEMS = 640;

__global__ void __launch_bounds__(512, 2) mk_fwd(MKArgs a) {
    extern __shared__ __attribute__((aligned(16))) unsigned char shm[];
    char* ws = a.ws;
    const int wg = blockIdx.x, nwg = gridDim.x;
    LAS int* tab = (LAS int*)(shm + LDS_TAB);
    LAS int* qslot = (LAS int*)(shm + LDS_TAB + 512);
    XcdBarrier bar = xcd_barrier_post((unsigned*)(ws + WS_CTL + CTL_BAR), (unsigned*)(ws + WS_CTL + CTL_BST) + 2 * wg);
    int* counts = (int*)(ws + WS_CTL);
    unsigned* qhead = (unsigned*)(ws + WS_CTL + CTL_QHEAD);
    p0_rmsnorm_bf16(a.x, a.g_mix, (bf16_t*)(ws + WB_HB), (unsigned char*)(ws + WB_HB8), wg, nwg);
    p0_rope(a.pos, (float*)(ws + WS_ROPE), wg, nwg);
    p0_transpose<false, false, true>(a.w_in, (bf16_t*)(ws + WB_WINT), D, INW, 1, (LAS unsigned*)shm, wg, nwg, (unsigned char*)(ws + WB_WINT8));
    p0_transpose(a.w_reto, (bf16_t*)(ws + WB_WRT), D, D, 1, (LAS unsigned*)shm, wg, nwg);
    p0_transpose(a.w_mobao, (bf16_t*)(ws + WB_WMT), D, D, 1, (LAS unsigned*)shm, wg, nwg);
    p0_transpose(a.w_out, (bf16_t*)(ws + WB_WOT), D, D, 1, (LAS unsigned*)shm, wg, nwg);
    xcd_barrier(bar);
    typedef BgConv<D, 2 * F> BgGu; typedef BgConv<F, D> BgDn;
    BgGu bg_gu; bg_gu.init(a.w_gu, (bf16_t*)(ws + WB_WGUT), ws + WB_SCR, NE, wg, nwg);
    BgOff bgoff;
    {
        P1PolicyT<false> p; p.hA = ws + WB_HB; p.WinT = ws + WB_WINT; p.projb = (bf16_t*)(ws + WB_PROJB); p.rope = (const float*)(ws + WS_ROPE); p.kpart = (float*)(ws + WB_KPART); p.G = nwg; p.c = wg;
        p.i0 = 0; p.icnt = 1 << 20; bg_gu.lanes(); g8::gemm_phase<P1PolicyT<false>, BgGu>((LAS unsigned char*)shm, p, bg_gu);
        P1PolicyT<true> p8; p8.hA = ws + WB_HB8; p8.WinT = ws + WB_WINT8; p8.projb = p.projb; p8.rope = p.rope; p8.kpart = p.kpart; p8.G = nwg; p8.c = wg;
        p8.i0 = 0; p8.icnt = 1 << 20; bg_gu.lanes(); g8::gemm_phase<P1PolicyT<true>, BgGu>((LAS unsigned char*)shm, p8, bg_gu);
    }
    xcd_barrier(bar);
    for (;;) {
        __syncthreads();
        int z = 0; asm volatile("" : "+v"(z));
        if (threadIdx.x == 0) qslot[z] = (int)__hip_atomic_fetch_add(qhead, 1u, __ATOMIC_RELAXED, __HIP_MEMORY_SCOPE_AGENT);
        __syncthreads();
        const int q = qslot[z];
        if (q >= P2_ITEMS) break;
        p2_item(q, (const bf16_t*)(ws + WB_PROJB), (const float*)(ws + WB_KPART), (bf16_t*)(ws + WB_OMOBAB), (bf16_t*)(ws + WB_ORETB), (LAS char*)shm);
    }
    xcd_barrier(bar);
    {
        P3Policy p; p.A0 = ws + WB_ORETB; p.A1 = ws + WB_OMOBAB; p.W0 = ws + WB_WRT; p.W1 = ws + WB_WMT; p.projb = (const bf16_t*)(ws + WB_PROJB); p.tmp = (float*)(ws + WS_YRET);
        p.merged = (bf16_t*)(ws + WB_MERGEDB); p.G = nwg; p.c = wg;
        bg_gu.lanes(); g8::gemm_phase<P3Policy, BgGu>((LAS unsigned char*)shm, p, bg_gu);
    }
    xcd_barrier(bar);
    {
        P4Policy p; p.A = ws + WB_MERGEDB; p.W = ws + WB_WOT; p.x = a.x; p.xmid = (float*)(ws + WS_XMID); p.G = nwg; p.c = wg;
        bg_gu.lanes(); g8::gemm_phase<P4Policy, BgGu>((LAS unsigned char*)shm, p, bg_gu);
    }
    xcd_barrier(bar);
    if (wg & 1) {
        p5_router((const float*)(ws + WS_XMID), a.g_ffn, a.r_w, a.r_b, (bf16_t*)(ws + WB_H2B), (int*)(ws + WS_TOPI), (int*)(ws + WS_SLOT), counts,
                  (int*)(ws + WB_LISTC), (float*)(ws + WB_ROWWC), (LAS float*)shm, wg, nwg);
        __syncthreads();
        p0_transpose<false, true>(a.w_gu, (bf16_t*)(ws + WB_WGUT), D, 2 * F, NE, (LAS unsigned*)shm, wg + nwg * (bg_gu.step >> 2), nwg);
    } else {
        p0_transpose<false, true>(a.w_gu, (bf16_t*)(ws + WB_WGUT), D, 2 * F, NE, (LAS unsigned*)shm, wg + nwg * (bg_gu.step >> 2), nwg);
        p5_router((const float*)(ws + WS_XMID), a.g_ffn, a.r_w, a.r_b, (bf16_t*)(ws + WB_H2B), (int*)(ws + WS_TOPI), (int*)(ws + WS_SLOT), counts,
                  (int*)(ws + WB_LISTC), (float*)(ws + WB_ROWWC), (LAS float*)shm, wg, nwg);
    }
    xcd_barrier(bar);
    build_tile_table(counts, tab);
    LAS int* udesc = (LAS int*)(shm + LDS_TAB + 1024);
    build_unit_desc(tab, wg, udesc);
    {
        P6Policy p; p.ud = udesc; p.h2b = ws + WB_H2B; p.WguT = ws + WB_WGUT; p.listc = (const int*)(ws + WB_LISTC); p.bgu = a.b_gu; p.act = (bf16_t*)(ws + WB_ACTB); p.tab = tab; p.G = nwg; p.c = wg;
        const int cls = (wg >> 3) & 3;
        if (cls > 0) { p.i0 = 0; p.icnt = 2 * cls; g8::gemm_phase<P6Policy, BgOff>((LAS unsigned char*)shm, p, bgoff); }
        p0_transpose<false, true>(a.w_dn, (bf16_t*)(ws + WB_WDNT), F, D, NE, (LAS unsigned*)shm, wg, nwg);
        p.i0 = 2 * cls; p.icnt = 1 << 20; g8::gemm_phase<P6Policy, BgOff>((LAS unsigned char*)shm, p, bgoff);
    }
    xcd_barrier(bar);
    {
        P7Policy p; p.ud = udesc; p.actb = ws + WB_ACTB; p.WdnT = ws + WB_WDNT; p.rowwc = (const float*)(ws + WB_ROWWC); p.bdn = a.b_dn; p.yrow = (bf16_t*)(ws + WB_YROWB); p.tab = tab; p.G = nwg; p.c = wg;
        g8::gemm_phase<P7Policy, BgOff>((LAS unsigned char*)shm, p, bgoff);
    }
    xcd_barrier(bar);
    p8_final((const float*)(ws + WS_XMID), (const bf16_t*)(ws + WB_YROWB), (const int*)(ws + WS_TOPI), (const int*)(ws + WS_SLOT), tab, a.g_fin, a.out, wg, nwg);
}

extern "C" void kernel_launch(void* const* d_in, const int* in_sizes, int n_in, void* d_out, int out_size, void* d_ws, size_t ws_size, hipStream_t stream) {
    static int grid = 0;
    if (grid == 0) {
        if (n_in != 15 || ws_size < WB_END2) { fprintf(stderr, "kernel_launch: bad arguments (n_in %d, ws %zu < %zu)\n", n_in, ws_size, (size_t)WB_END2); grid = -1; return; }
        int dev = 0, cus = 0, per_cu = 0;
        if (hipGetDevice(&dev) != hipSuccess || hipDeviceGetAttribute(&cus, hipDeviceAttributeMultiprocessorCount, dev) != hipSuccess) { grid = -1; return; }
        if (hipFuncSetAttribute((const void*)mk_fwd, hipFuncAttributeMaxDynamicSharedMemorySize, LDS_BYTES) != hipSuccess) { fprintf(stderr, "kernel_launch: hipFuncSetAttribute failed\n"); grid = -1; return; }
        if (hipOccupancyMaxActiveBlocksPerMultiprocessor(&per_cu, (const void*)mk_fwd, 512, LDS_BYTES) != hipSuccess || per_cu < 1) { fprintf(stderr, "kernel_launch: occupancy query says %d\n", per_cu); per_cu = 1; }
        grid = cus;
    }
    if (grid < 0) return;
    char* ws = (char*)d_ws;
    (void)hipMemsetAsync(ws + WS_CTL, 0, CTL_BYTES, stream);
    MKArgs ma{};
    ma.x = (const float*)d_in[0]; ma.pos = (const int*)d_in[1]; ma.g_mix = (const float*)d_in[2]; ma.w_in = (const float*)d_in[3];
    ma.w_reto = (const float*)d_in[4]; ma.w_mobao = (const float*)d_in[5]; ma.w_out = (const float*)d_in[6]; ma.g_ffn = (const float*)d_in[7];
    ma.r_w = (const float*)d_in[8]; ma.r_b = (const float*)d_in[9]; ma.w_gu = (const float*)d_in[10]; ma.b_gu = (const float*)d_in[11];
    ma.w_dn = (const float*)d_in[12]; ma.b_dn = (const float*)d_in[13]; ma.g_fin = (const float*)d_in[14]; ma.out = (float*)d_out; ma.ws = ws;
    hipLaunchKernelGGL(mk_fwd, dim3(grid), dim3(512), LDS_BYTES, stream, ma);
}
```
